# Optimizing an MI355X kernel written in HIP

```python
import math
import jax, jax.numpy as jnp
from jax import lax
import numpy as np

D_MODEL = 1024
BATCH = 8
SEQ = 8192
DEPTH = 2

GRID_W = 64
CTX_LEN = 256
N_MIXERS = 2
N_HG_LAYERS = (DEPTH + N_MIXERS - 1) // N_MIXERS
N_DA_LAYERS = DEPTH // N_MIXERS
HG_HEADS = D_MODEL // 128
HG_DK = 128
HG_DV = D_MODEL // HG_HEADS
HG_CHUNK = 64
DA_HEADS = 8
DA_DH = D_MODEL // DA_HEADS // 2
DA_DV = 2 * DA_DH
Q_BLOCK = 128
ROPE_BASE = 10000.0
N_EXPERTS = 32
TOP_K = 4
D_EXPERT = D_MODEL
SWIGLU_LIMIT = 7.0
SWIGLU_ALPHA = 1.702
MOE_BLOCK = 128
DN_ALPHA = (2 * DEPTH) ** 0.25
DN_BETA = (8 * DEPTH) ** -0.25
LN_EPS = 1e-5
RMS_EPS = 1e-6

kernel_name = 'hybrid_hgrn2_diffattn_moe_dit'


def layer_norm(x, g, b):
    xf = x.astype(jnp.float32)
    mu = jnp.mean(xf, axis=-1, keepdims=True)
    var = jnp.mean(jnp.square(xf - mu), axis=-1, keepdims=True)
    y = (xf - mu) * lax.rsqrt(var + LN_EPS) * g.astype(jnp.float32) + b.astype(jnp.float32)
    return y.astype(x.dtype)


def rms_norm(x, g):
    xf = x.astype(jnp.float32)
    return xf * lax.rsqrt(jnp.mean(xf * xf, axis=-1, keepdims=True) + RMS_EPS) * g.astype(jnp.float32)


def rope_2d(t):
    L = t.shape[1]
    rows_n = L // GRID_W
    row = jnp.repeat(jnp.arange(rows_n), GRID_W)
    col = jnp.tile(jnp.arange(GRID_W), rows_n)
    half = t.shape[-1] // 2
    n_freq = half // 2
    inv = ROPE_BASE ** (-jnp.arange(n_freq, dtype=jnp.float32) / n_freq)

    def rot(u, pos):
        ang = pos.astype(jnp.float32)[:, None] * inv[None, :]
        cos = jnp.cos(ang)[None, :, None, :]
        sin = jnp.sin(ang)[None, :, None, :]
        u1, u2 = jnp.split(u, 2, axis=-1)
        return jnp.concatenate([u1 * cos - u2 * sin, u1 * sin + u2 * cos], axis=-1)

    tf = t.astype(jnp.float32)
    out = jnp.concatenate([rot(tf[..., :half], row), rot(tf[..., half:], col)], axis=-1)
    return out.astype(t.dtype)


def gla_chunkwise(q, k, v, logf, s0):
    bsz, L, H, _ = q.shape
    DV = v.shape[-1]
    n = L // HG_CHUNK

    def chunks(t):
        return t.reshape(bsz, n, HG_CHUNK, H, t.shape[-1]).transpose(1, 0, 3, 2, 4)

    qc, kc, vc, gc = chunks(q), chunks(k), chunks(v), chunks(logf)
    b = jnp.cumsum(gc, axis=3)
    b_end = b[:, :, :, -1:, :]
    q_dec = qc * jnp.exp(b)
    k_inv = kc * jnp.exp(-b)
    k_end = kc * jnp.exp(b_end - b)
    tri = jnp.tril(jnp.ones((HG_CHUNK, HG_CHUNK), dtype=bool))
    a = jnp.where(tri, jnp.einsum('nbhtk,nbhsk->nbhts', q_dec, k_inv), 0.0)
    o_intra = jnp.einsum('nbhts,nbhsv->nbhtv', a, vc)

    def step(state, xs):
        qn, kn, vn, dn = xs
        o = jnp.einsum('bhtk,bhkv->bhtv', qn, state)
        state = state * jnp.exp(dn)[..., None] + jnp.einsum('bhsk,bhsv->bhkv', kn, vn)
        return state, o

    s_final, o_inter = lax.scan(step, s0, (q_dec, k_end, vc, b_end[:, :, :, 0, :]))
    o = (o_intra + o_inter).transpose(1, 0, 3, 2, 4).reshape(bsz, L, H, DV)
    return o, s_final


def hgrn2_mixer(h_lat, h_ctx, w_in, lb_tab, norm_g, w_out, layer, need_ctx):
    lb = jnp.cumsum(jax.nn.softmax(lb_tab.astype(jnp.float32), axis=1), axis=1)[:, layer]
    lb = lb.reshape(2, HG_HEADS, HG_DK)

    def heads(t):
        return t.reshape(t.shape[0], t.shape[1], HG_HEADS, -1).astype(jnp.float32)

    def project(h):
        q, i, g, zf, zb = jnp.split(h @ w_in, 5, axis=-1)
        return heads(q), heads(i), g, (heads(zf), heads(zb))

    def scan_dir(q, i, z, lbd, s0, reverse):
        if reverse:
            q, i, z = jnp.flip(q, 1), jnp.flip(i, 1), jnp.flip(z, 1)
        f = lbd + (1.0 - lbd) * jax.nn.sigmoid(z)
        o, s = gla_chunkwise(q, 1.0 - f, i, jnp.log(f), s0)
        if reverse:
            o = jnp.flip(o, 1)
        return o, s

    def readout(o, g):
        o = rms_norm(o, norm_g.reshape(HG_HEADS, HG_DV)) * jax.nn.silu(heads(g))
        return o.reshape(o.shape[0], o.shape[1], D_MODEL).astype(w_out.dtype) @ w_out

    qc, ic, gc, zc = project(h_ctx)
    ql, il, gl, zl = project(h_lat)
    s0 = jnp.zeros((h_ctx.shape[0], HG_HEADS, HG_DK, HG_DV), jnp.float32)
    oc_f, sc_f = scan_dir(qc, ic, zc[0], lb[0], s0, False)
    oc_b, sc_b = scan_dir(qc, ic, zc[1], lb[1], s0, True)
    ol_f, _ = scan_dir(ql, il, zl[0], lb[0], sc_f, False)
    ol_b, _ = scan_dir(ql, il, zl[1], lb[1], sc_b, True)
    out_lat = readout(ol_f + ol_b, gl)
    out_ctx = readout(oc_f + oc_b, gc) if need_ctx else None
    return out_lat, out_ctx


def diff_attn_mixer(h_lat, h_ctx, w_in, lam_p, norm_g, w_out, layer, need_ctx):
    lam_init = 0.8 - 0.6 * math.exp(-0.3 * layer)
    lp = lam_p.astype(jnp.float32)
    lam = jnp.exp(jnp.sum(lp[0] * lp[1])) - jnp.exp(jnp.sum(lp[2] * lp[3])) + lam_init
    w_q, w_kv = w_in[:, :D_MODEL], w_in[:, D_MODEL:]

    def proj_q(h):
        return (h @ w_q).reshape(h.shape[0], h.shape[1], 2 * DA_HEADS, DA_DH)

    def proj_kv(h):
        k, v = jnp.split(h @ w_kv, 2, axis=-1)
        return (k.reshape(h.shape[0], h.shape[1], 2 * DA_HEADS, DA_DH),
                v.reshape(h.shape[0], h.shape[1], DA_HEADS, DA_DV))

    def maps(t):
        return t.reshape(t.shape[0], t.shape[1], DA_HEADS, 2, DA_DH)

    def attend(qb, k, v):
        s = jnp.einsum('bqhcd,bkhcd->bhcqk', qb, k).astype(jnp.float32) * (DA_DH ** -0.5)
        p = jax.nn.softmax(s, axis=-1)
        w = p[:, :, 0] - lam * p[:, :, 1]
        return jnp.einsum('bhqk,bkhv->bqhv', w.astype(v.dtype), v)

    def readout(o):
        o = rms_norm(o, norm_g) * (1.0 - lam_init)
        return o.reshape(o.shape[0], o.shape[1], D_MODEL).astype(w_out.dtype) @ w_out

    ql = rope_2d(proj_q(h_lat))
    kl, vl = proj_kv(h_lat)
    kl = rope_2d(kl)
    kc, vc = proj_kv(h_ctx)
    k_all = maps(jnp.concatenate([kl, kc], axis=1))
    v_all = jnp.concatenate([vl, vc], axis=1)
    bsz, L = ql.shape[0], ql.shape[1]
    nb = L // Q_BLOCK
    q_blocks = maps(ql).reshape(bsz, nb, Q_BLOCK, DA_HEADS, 2, DA_DH).transpose(1, 0, 2, 3, 4, 5)
    o_lat = lax.map(lambda qb: attend(qb, k_all, v_all), q_blocks)
    o_lat = o_lat.transpose(1, 0, 2, 3, 4).reshape(bsz, L, DA_HEADS, DA_DV)
    out_lat = readout(o_lat)
    out_ctx = readout(attend(maps(proj_q(h_ctx)), maps(kc), vc)) if need_ctx else None
    return out_lat, out_ctx


def moe_ffn(h, w_r, b_r, w_gu, b_gu, w_dn, b_dn):
    T, D = h.shape
    logits = (h @ w_r + b_r).astype(jnp.float32)
    top_v, top_i = lax.top_k(logits, TOP_K)
    gates = jax.nn.softmax(top_v, axis=-1)
    A = T * TOP_K
    e_flat = top_i.reshape(-1)
    order = jnp.argsort(e_flat, stable=True)
    e_sorted = e_flat[order]
    tok_sorted = order // TOP_K
    g_sorted = gates.reshape(-1)[order].astype(h.dtype)
    counts = jnp.bincount(e_flat, length=N_EXPERTS)
    padded = (counts + MOE_BLOCK - 1) // MOE_BLOCK * MOE_BLOCK
    start = jnp.cumsum(counts) - counts
    pend = jnp.cumsum(padded)
    pstart = pend - padded
    dest = pstart[e_sorted] + (jnp.arange(A) - start[e_sorted])
    n_blocks = -(-A // MOE_BLOCK) + N_EXPERTS
    buf = jnp.zeros((n_blocks * MOE_BLOCK, D), h.dtype).at[dest].set(h[tok_sorted])
    block_expert = jnp.minimum(jnp.searchsorted(pend, jnp.arange(n_blocks) * MOE_BLOCK, side='right'), N_EXPERTS - 1)

    def expert_block(args):
        xb, e = args
        gate, up = jnp.split(xb @ w_gu[e] + b_gu[e], 2, axis=-1)
        gate = jnp.minimum(gate, SWIGLU_LIMIT)
        up = jnp.clip(up, -SWIGLU_LIMIT, SWIGLU_LIMIT)
        act = (up + 1.0) * gate * jax.nn.sigmoid(SWIGLU_ALPHA * gate)
        return act @ w_dn[e] + b_dn[e]

    out = lax.map(expert_block, (buf.reshape(n_blocks, MOE_BLOCK, D), block_expert)).reshape(-1, D)
    return jax.ops.segment_sum(out[dest] * g_sorted[:, None], tok_sorted, num_segments=T)


def setup_inputs(seed: int = 0) -> dict:
    key = jax.random.key(seed)
    ks = jax.random.split(key, 22)
    D = D_MODEL

    def nrm(k, shape, scale):
        return jax.random.normal(k, shape, jnp.float32) * scale

    return {
        'x': nrm(ks[0], (BATCH, SEQ, D), 1.0),
        'c': nrm(ks[1], (BATCH, D), 1.0),
        'ctx': nrm(ks[2], (BATCH, CTX_LEN, D), 1.0),
        'c_ctx': nrm(ks[3], (D,), 1.0),
        'w_ada': nrm(ks[4], (DEPTH, D, 6 * D), 0.5 * D ** -0.5),
        'b_ada': nrm(ks[5], (DEPTH, 6 * D), 0.02),
        'ln_g': 1.0 + nrm(ks[6], (DEPTH, 2, D), 0.02),
        'ln_b': nrm(ks[7], (DEPTH, 2, D), 0.02),
        'hg_w_in': nrm(ks[8], (N_HG_LAYERS, D, 5 * D), D ** -0.5),
        'hg_lb': nrm(ks[9], (2, DEPTH + 1, HG_HEADS * HG_DK), 0.1),
        'hg_norm_g': 1.0 + nrm(ks[10], (N_HG_LAYERS, D), 0.02),
        'hg_w_out': nrm(ks[11], (N_HG_LAYERS, D, D), DN_BETA * D ** -0.5),
        'da_w_in': nrm(ks[12], (N_DA_LAYERS, D, 3 * D), D ** -0.5),
        'da_lam': nrm(ks[13], (N_DA_LAYERS, 4, DA_DH), 0.1),
        'da_norm_g': 1.0 + nrm(ks[14], (N_DA_LAYERS, DA_DV), 0.02),
        'da_w_out': nrm(ks[15], (N_DA_LAYERS, D, D), DN_BETA * D ** -0.5),
        'moe_w_router': nrm(ks[16], (DEPTH, D, N_EXPERTS), D ** -0.5),
        'moe_b_router': nrm(ks[17], (DEPTH, N_EXPERTS), 0.01),
        'moe_w_gu': nrm(ks[18], (DEPTH, N_EXPERTS, D, 2 * D_EXPERT), D ** -0.5),
        'moe_b_gu': nrm(ks[19], (DEPTH, N_EXPERTS, 2 * D_EXPERT), 0.01),
        'moe_w_dn': nrm(ks[20], (DEPTH, N_EXPERTS, D_EXPERT, D), DN_BETA * D_EXPERT ** -0.5),
        'moe_b_dn': nrm(ks[21], (DEPTH, N_EXPERTS, D), 0.01),
    }


def reference(x, c, ctx, c_ctx, w_ada, b_ada, ln_g, ln_b, hg_w_in, hg_lb, hg_norm_g, hg_w_out,
              da_w_in, da_lam, da_norm_g, da_w_out, moe_w_router, moe_b_router, moe_w_gu, moe_b_gu,
              moe_w_dn, moe_b_dn):
    bsz, L, D = x.shape
    xl, xc = x, ctx
    silu_c = jax.nn.silu(c)
    silu_cc = jax.nn.silu(c_ctx)
    for l in range(DEPTH):
        last = l == DEPTH - 1
        j = l // N_MIXERS
        mod_l = (silu_c @ w_ada[l] + b_ada[l])[:, None, :]
        mod_c = (silu_cc @ w_ada[l] + b_ada[l])[None, None, :]
        sh1, sc1, g1, sh2, sc2, g2 = jnp.split(mod_l, 6, axis=-1)
        csh1, csc1, cg1, csh2, csc2, cg2 = jnp.split(mod_c, 6, axis=-1)
        hl = xl * (1.0 + sc1) + sh1
        hc = xc * (1.0 + csc1) + csh1
        if l % N_MIXERS == 0:
            ml, mc = hgrn2_mixer(hl, hc, hg_w_in[j], hg_lb, hg_norm_g[j], hg_w_out[j], l, not last)
        else:
            ml, mc = diff_attn_mixer(hl, hc, da_w_in[j], da_lam[j], da_norm_g[j], da_w_out[j], l, not last)
        xl = layer_norm(DN_ALPHA * xl + g1 * ml, ln_g[l, 0], ln_b[l, 0])
        hl2 = (xl * (1.0 + sc2) + sh2).reshape(-1, D)
        if last:
            f = moe_ffn(hl2, moe_w_router[l], moe_b_router[l], moe_w_gu[l], moe_b_gu[l], moe_w_dn[l], moe_b_dn[l])
            xl = layer_norm(DN_ALPHA * xl + g2 * f.reshape(bsz, L, D), ln_g[l, 1], ln_b[l, 1])
        else:
            xc = layer_norm(DN_ALPHA * xc + cg1 * mc, ln_g[l, 0], ln_b[l, 0])
            hc2 = (xc * (1.0 + csc2) + csh2).reshape(-1, D)
            f = moe_ffn(jnp.concatenate([hl2, hc2], axis=0), moe_w_router[l], moe_b_router[l],
                        moe_w_gu[l], moe_b_gu[l], moe_w_dn[l], moe_b_dn[l])
            fl = f[:bsz * L].reshape(bsz, L, D)
            fc = f[bsz * L:].reshape(xc.shape)
            xl = layer_norm(DN_ALPHA * xl + g2 * fl, ln_g[l, 1], ln_b[l, 1])
            xc = layer_norm(DN_ALPHA * xc + cg2 * fc, ln_g[l, 1], ln_b[l, 1])
    return xl
```

```cpp
#include <hip/hip_runtime.h>
#include <cstdio>
#include <cstdint>
#include <type_traits>

constexpr int D = 1024, NB = 8, SEQ = 8192, CTXL = 256;
constexpr int TL = NB * SEQ, TC = NB * CTXL, TT = TL + TC;
constexpr int NE = 32, CAP = TT;
constexpr int HGN = 5120, DAN = 3072;
constexpr float DN_ALPHA = 1.4142135623730951f;
constexpr float LN_EPS = 1e-5f, RMS_EPS = 1e-6f;
constexpr float LAM_INIT = 0.35550906759f;
constexpr float QSCALE = 0.125f * 1.4426950408889634f;
constexpr int NWAVES = 8;

constexpr size_t MiB = 1u << 20;
constexpr size_t WS_CTL = 0, CTL_ZERO_BYTES = 1 * MiB;
constexpr int CW_TMO = 0, CW_CODE = 1, CW_BAR = 4096, CW_CNT = 8192;
constexpr size_t WS_MOD = 64 * 1024;
constexpr size_t WS_TAB = 1 * MiB;
constexpr int TAB_COS = 0, TAB_SIN = 2048, TAB_LB = 4096, TAB_LAM = 6144;
constexpr size_t WS_TI = 2 * MiB;
constexpr size_t WS_LIST = 6 * MiB;
constexpr size_t WS_WHGIN = 32 * MiB, WS_WHGOUT = 42 * MiB, WS_WDAIN = 44 * MiB, WS_WDAOUT = 50 * MiB, WS_WGU = 52 * MiB, WS_WDN = 308 * MiB;
constexpr size_t WS_R1 = 436 * MiB, WS_R2 = 1096 * MiB, WS_R3 = 1640 * MiB, WS_END = 1904 * MiB;
constexpr size_t ROWB = 2048;
constexpr size_t WS_PROJ0 = WS_R1;
constexpr size_t WS_ACT = WS_R1;
constexpr size_t WS_QKV = WS_R1;
constexpr size_t WS_QK8 = WS_R1, WS_VB = WS_R1 + 132 * MiB, WS_VT8 = WS_R1 + 264 * MiB;
constexpr size_t WS_O = WS_R1 + 396 * MiB;
constexpr size_t WS_OF = WS_R2, WS_OB = WS_R2 + 132 * MiB, WS_ARO = WS_R2 + 264 * MiB, WS_ML = WS_R2 + 396 * MiB;
constexpr size_t WS_Y = WS_R2;
constexpr size_t WS_XL = WS_R3;

constexpr int RING_BYTES = 131072;
constexpr int MISC_OFF = RING_BYTES;
constexpr int LDS_BYTES = 147456;

#define GAS __attribute__((address_space(1)))
#define LAS __attribute__((address_space(3)))
typedef unsigned short u16;
typedef unsigned v4u __attribute__((ext_vector_type(4)));
typedef unsigned v2u __attribute__((ext_vector_type(2)));
typedef float f32x4 __attribute__((ext_vector_type(4)));
typedef float f32x2 __attribute__((ext_vector_type(2)));

__device__ __forceinline__ unsigned f2bf(float f) { unsigned u = __builtin_bit_cast(unsigned, f); return (u + 0x7fffu + ((u >> 16) & 1u)) >> 16; }
__device__ __forceinline__ unsigned pk2(float lo, float hi) { return f2bf(lo) | (f2bf(hi) << 16); }
__device__ __forceinline__ float bf2f(unsigned h) { return __builtin_bit_cast(float, h << 16); }
__device__ __forceinline__ float bflo(unsigned w) { return __builtin_bit_cast(float, w << 16); }
__device__ __forceinline__ float bfhi(unsigned w) { return __builtin_bit_cast(float, w & 0xffff0000u); }
__device__ __forceinline__ unsigned f2h(float f) { _Float16 h = (_Float16)f; return (unsigned)__builtin_bit_cast(unsigned short, h); }
__device__ __forceinline__ float h2f(unsigned h) { return (float)__builtin_bit_cast(_Float16, (unsigned short)h); }
__device__ __forceinline__ float sigmoidf_(float x) { return __builtin_amdgcn_rcpf(1.0f + __builtin_amdgcn_exp2f(x * -1.4426950408889634f)); }
__device__ __forceinline__ float wave_sum(float v) {
#pragma unroll
    for (int o = 1; o < 16; o <<= 1) v += __shfl_xor(v, o);
    { const auto s16 = __builtin_amdgcn_permlane16_swap(__float_as_uint(v), __float_as_uint(v), false, false); v = __uint_as_float(s16[0]) + __uint_as_float(s16[1]); }
    { const auto s32 = __builtin_amdgcn_permlane32_swap(__float_as_uint(v), __float_as_uint(v), false, false); v = __uint_as_float(s32[0]) + __uint_as_float(s32[1]); }
    return v;
}

namespace pg8 {
#define PG8_LAS __attribute__((address_space(3)))
typedef unsigned short bf16_t;
typedef short bf16x8 __attribute__((ext_vector_type(8)));
typedef float f32x4 __attribute__((ext_vector_type(4)));
typedef unsigned u32x4 __attribute__((ext_vector_type(4)));
typedef unsigned u32x2 __attribute__((ext_vector_type(2)));
constexpr int BM = 256, BK = 64, HALF = 128, HTB = HALF * BK * 2, STAGE_BYTES = 8 * HTB, NXCD = 8, WGM = 8, KD = 1024;

__host__ __device__ __forceinline__ int lds_byte(int r, int c) { const int st = (r >> 4) * 2 + (c >> 5), rr = r & 15, cc = c & 31, ob = rr * 64 + cc * 2; return st * 1024 + (ob ^ (((ob >> 9) & 1) << 5)); }
__host__ __device__ __forceinline__ void stage_rc(int b, int& R, int& C) { const int st = b / 1024, sb = b % 1024, swz = sb ^ (((sb >> 9) & 1) << 5); R = (st >> 1) * 16 + swz / 64; C = (st & 1) * 32 + (swz % 64) / 2; }
__host__ __device__ __forceinline__ int perm32(int rho) { const int n = rho >> 4, i = rho & 15; return 8 * (i >> 2) + 4 * n + (i & 3); }

struct Unit { int pm, pn, e; };

struct StaticOrder {
    int nM, nN, nwg, G, c;
    __device__ void init(int M, int N, int G_, int c_) { nM = M / BM; nN = N / BM; nwg = nM * nN; G = G_; c = c_; }
    __device__ bool next(int i, Unit& u) const {
        const long L = (long)i * G + c; if (L >= nwg) return false;
        int wgid = (int)L; { const int q = nwg / NXCD, r = nwg % NXCD, xcd = wgid % NXCD, off = wgid / NXCD; wgid = (xcd < r ? xcd * (q + 1) : r * (q + 1) + (xcd - r) * q) + off; }
        const int nig = WGM * nN, gid = wgid / nig, fm = gid * WGM, gsz = (nM - fm) < WGM ? (nM - fm) : WGM;
        u.pm = fm + ((wgid % nig) % gsz); u.pn = (wgid % nig) / gsz; u.e = 0; return true;
    }
};
struct MoeOrder {
    const PG8_LAS int* tp; int nct, G, c, rev;
    __device__ bool next(int i, Unit& u) const {
        int rt, ct, e = 0;
        if (G == 256) {
            const int x = c & 7, j = c >> 3, rpx = 32 / nct; int q = i * rpx + j / nct; ct = j % nct;
            int k = 0; e = rev ? x + 24 : x;
#pragma unroll 1
            for (; k < 4; ++k) { const int n = tp[e + 1] - tp[e]; if (q < n) break; q -= n; e += rev ? -8 : 8; }
            if (k == 4) return false;
            rt = rev ? tp[e + 1] - 1 - q : tp[e] + q; }
        else { const int total = tp[32] * nct; const long L = (long)i * G + c; if (L >= total) return false; rt = (int)L / nct; ct = (int)L % nct; if (rev) rt = tp[32] - 1 - rt;
#pragma unroll 1
            for (int j = 1; j < 32; ++j) e += (tp[j] <= rt) ? 1 : 0; }
        u.pm = __builtin_amdgcn_readfirstlane(rt); u.pn = __builtin_amdgcn_readfirstlane(ct); u.e = __builtin_amdgcn_readfirstlane(e); return true;
    }
};
struct DenseAB { const bf16_t* A; const bf16_t* Bt;
    __device__ __forceinline__ const char* a_base(const Unit& u) const { return (const char*)A + (size_t)u.pm * (BM * KD * 2); }
    __device__ __forceinline__ const char* b_base(const Unit& u) const { return (const char*)Bt + (size_t)u.pn * (BM * KD * 2); }
    __device__ __forceinline__ void a_offs(const Unit&, const int (&R)[2], const int (&C)[2], unsigned (&v)[2][2]) const {
#pragma unroll
        for (int h = 0; h < 2; ++h)
#pragma unroll
            for (int i = 0; i < 2; ++i) v[h][i] = (unsigned)((h * HALF + R[i]) * KD + C[i]) * 2u; }
};
struct MoeDnAB { const bf16_t* A; const bf16_t* Bt;
    __device__ __forceinline__ const char* a_base(const Unit& u) const { return (const char*)A + (size_t)u.pm * (BM * KD * 2); }
    __device__ __forceinline__ const char* b_base(const Unit& u) const { return (const char*)Bt + (size_t)u.e * (1024 * KD * 2) + (size_t)u.pn * (BM * KD * 2); }
    __device__ __forceinline__ void a_offs(const Unit&, const int (&R)[2], const int (&C)[2], unsigned (&v)[2][2]) const {
#pragma unroll
        for (int h = 0; h < 2; ++h)
#pragma unroll
            for (int i = 0; i < 2; ++i) v[h][i] = (unsigned)((h * HALF + R[i]) * KD + C[i]) * 2u; }
};
struct MoeGuAB { const bf16_t* A; const bf16_t* Bt; const int* list; const PG8_LAS int* tp; const PG8_LAS int* cnt;
    __device__ __forceinline__ const char* a_base(const Unit&) const { return (const char*)A; }
    __device__ __forceinline__ const char* b_base(const Unit& u) const { return (const char*)Bt + (size_t)u.e * (2048 * KD * 2) + (size_t)u.pn * (BM * KD * 2); }
    __device__ __forceinline__ void a_offs(const Unit& u, const int (&R)[2], const int (&C)[2], unsigned (&v)[2][2]) const {
        const int r0 = (u.pm - tp[u.e]) * BM, n = cnt[u.e];
#pragma unroll
        for (int h = 0; h < 2; ++h)
#pragma unroll
            for (int i = 0; i < 2; ++i) { const int rank = r0 + h * HALF + R[i]; int tok = list[(size_t)u.e * CAP + rank]; tok = rank < n ? tok : 0;
                v[h][i] = (unsigned)(tok * KD + C[i]) * 2u; } }
};

__device__ __forceinline__ unsigned cvt_pk_bf16(float lo, float hi) { unsigned r; asm volatile("v_cvt_pk_bf16_f32 %0, %1, %2" : "=v"(r) : "v"(lo), "v"(hi)); return r; }
__device__ __forceinline__ unsigned pk4_fp8(float a, float b, float c, float d);

struct EpiBf16 {
    static constexpr bool PERM = true;
    bf16_t* O; int ldc; const float* bias; int bias_stride; float ascale;
    __device__ __forceinline__ void operator()(const f32x4 (&acc)[2][2][4][2], const Unit& u, int wr, int wc, int fr, int fq) const {
        const int row0 = u.pm * BM + wr * 64 + fr, col0 = u.pn * BM + wc * 32 + 8 * fq;
        f32x4 bv[2][2];
#pragma unroll
        for (int bj = 0; bj < 2; ++bj)
#pragma unroll
            for (int n = 0; n < 2; ++n) bv[bj][n] = bias ? *(const f32x4*)(bias + (size_t)u.e * bias_stride + col0 + bj * HALF + 4 * n) : (f32x4){0.f, 0.f, 0.f, 0.f};
#pragma unroll
        for (int ai = 0; ai < 2; ++ai)
#pragma unroll
            for (int m = 0; m < 4; ++m) { bf16_t* rowp = O + (size_t)(row0 + ai * HALF + m * 16) * ldc + col0;
#pragma unroll
                for (int bj = 0; bj < 2; ++bj) { const f32x4 v0 = acc[ai][bj][m][0] * ascale + bv[bj][0], v1 = acc[ai][bj][m][1] * ascale + bv[bj][1];
                    u32x4 w; w.x = cvt_pk_bf16(v0[0], v0[1]); w.y = cvt_pk_bf16(v0[2], v0[3]); w.z = cvt_pk_bf16(v1[0], v1[1]); w.w = cvt_pk_bf16(v1[2], v1[3]);
                    *(u32x4*)(rowp + bj * HALF) = w; } }
    }
};
struct EpiHgProj {
    static constexpr bool PERM = true;
    bf16_t* P; const float* lb; float ascale;
    __device__ __forceinline__ void operator()(const f32x4 (&acc)[2][2][4][2], const Unit& u, int wr, int wc, int fr, int fq) const {
        const int row0 = u.pm * BM + wr * 64 + fr, col0 = u.pn * BM + wc * 32 + 8 * fq;
        const bool isz = (u.pn >= 12);
        f32x4 lbv[2][2];
#pragma unroll
        for (int bj = 0; bj < 2; ++bj)
#pragma unroll
            for (int n = 0; n < 2; ++n) lbv[bj][n] = isz ? *(const f32x4*)(lb + (col0 - 3072) + bj * HALF + 4 * n) : (f32x4){0.f, 0.f, 0.f, 0.f};
#pragma unroll
        for (int ai = 0; ai < 2; ++ai)
#pragma unroll
            for (int m = 0; m < 4; ++m) { bf16_t* rowp = P + (size_t)(row0 + ai * HALF + m * 16) * HGN + col0;
#pragma unroll
                for (int bj = 0; bj < 2; ++bj) { u32x4 w;
                    if (!isz) { const f32x4 v0 = acc[ai][bj][m][0] * ascale, v1 = acc[ai][bj][m][1] * ascale;
                        w.x = cvt_pk_bf16(v0[0], v0[1]); w.y = cvt_pk_bf16(v0[2], v0[3]); w.z = cvt_pk_bf16(v1[0], v1[1]); w.w = cvt_pk_bf16(v1[2], v1[3]); }
                    else { float lf[8];
#pragma unroll
                        for (int n = 0; n < 2; ++n)
#pragma unroll
                            for (int i = 0; i < 4; ++i) { const float z = acc[ai][bj][m][n][i] * ascale, l = lbv[bj][n][i]; const float f = l + (1.0f - l) * sigmoidf_(z); lf[n * 4 + i] = __builtin_amdgcn_logf(f); }
                        w.x = f2h(lf[0]) | (f2h(lf[1]) << 16); w.y = f2h(lf[2]) | (f2h(lf[3]) << 16); w.z = f2h(lf[4]) | (f2h(lf[5]) << 16); w.w = f2h(lf[6]) | (f2h(lf[7]) << 16); }
                    if (u.pn >= 8 && u.pn < 12) __builtin_nontemporal_store(w, (u32x4*)(rowp + bj * HALF));
                    else *(u32x4*)(rowp + bj * HALF) = w; } }
    }
};
struct EpiGU {
    static constexpr bool PERM = true;
    bf16_t* ACT; const float* bgu;
    __device__ __forceinline__ void operator()(const f32x4 (&acc)[2][2][4][2], const Unit& u, int wr, int wc, int fr, int fq) const {
        const int row0 = u.pm * BM + wr * 64 + fr, j0 = u.pn * HALF + wc * 32 + 8 * fq;
        const float* bg = bgu + (size_t)u.e * 2048 + j0;
        f32x4 bgv[2], buv[2];
#pragma unroll
        for (int n = 0; n < 2; ++n) { bgv[n] = *(const f32x4*)(bg + 4 * n); buv[n] = *(const f32x4*)(bg + 1024 + 4 * n); }
#pragma unroll
        for (int ai = 0; ai < 2; ++ai)
#pragma unroll
            for (int m = 0; m < 4; ++m) { float a[8];
#pragma unroll
                for (int n = 0; n < 2; ++n)
#pragma unroll
                    for (int i = 0; i < 4; ++i) { float g = acc[ai][0][m][n][i] + bgv[n][i], up = acc[ai][1][m][n][i] + buv[n][i];
                        g = fminf(g, 7.0f); up = fminf(fmaxf(up, -7.0f), 7.0f); a[n * 4 + i] = (up + 1.0f) * g * sigmoidf_(1.702f * g); }
                u32x4 w; w.x = cvt_pk_bf16(a[0], a[1]); w.y = cvt_pk_bf16(a[2], a[3]); w.z = cvt_pk_bf16(a[4], a[5]); w.w = cvt_pk_bf16(a[6], a[7]);
                *(u32x4*)(ACT + (size_t)(row0 + ai * HALF + m * 16) * 1024 + j0) = w; }
    }
};
struct EpiDaProj {
    static constexpr bool PERM = false;
    unsigned char* QK8; bf16_t* VB; const float* tab; float ascale;
    __device__ __forceinline__ void operator()(const f32x4 (&acc)[2][2][4][2], const Unit& u, int wr, int wc, int fr, int fq) const {
        const int row0 = u.pm * BM + wr * 64 + fr, col0 = u.pn * BM + wc * 32 + 4 * fq;
        const bool rot = (u.pn < 8) && (u.pm < TL / BM);
        const float sc = ((u.pn < 4) ? QSCALE : 1.0f) * ascale;
#pragma unroll
        for (int ai = 0; ai < 2; ++ai)
#pragma unroll
            for (int m = 0; m < 4; ++m) { const int row = row0 + ai * HALF + m * 16;
                f32x4 cs = {1.f, 1.f, 1.f, 1.f}, sn = {0.f, 0.f, 0.f, 0.f};
                if (rot) { const int t = row & (SEQ - 1); const int pos = (wc & 1) ? (t & 63) : (t >> 6); cs = *(const f32x4*)(tab + TAB_COS + pos * 16 + 4 * fq); sn = *(const f32x4*)(tab + TAB_SIN + pos * 16 + 4 * fq); }
#pragma unroll
                for (int bj = 0; bj < 2; ++bj) { const f32x4 u1 = acc[ai][bj][m][0], u2 = acc[ai][bj][m][1];
                    const f32x4 o1 = (u1 * cs - u2 * sn) * sc, o2 = (u1 * sn + u2 * cs) * sc;
                    if (u.pn < 8) { unsigned char* p = QK8 + (size_t)row * 2048 + col0 + bj * HALF; *(unsigned*)p = pk4_fp8(o1[0], o1[1], o1[2], o1[3]); *(unsigned*)(p + 16) = pk4_fp8(o2[0], o2[1], o2[2], o2[3]); }
                    else { unsigned char* p = (unsigned char*)VB + (size_t)row * 1024 + (col0 - 2048) + bj * HALF; *(unsigned*)p = pk4_fp8(o1[0], o1[1], o1[2], o1[3]); *(unsigned*)(p + 16) = pk4_fp8(o2[0], o2[1], o2[2], o2[3]); } }
                asm volatile("" ::: "memory"); }
    }
};

template <class Epi, class Sched, class AM, bool ALIGN_EPI, bool SP2>
__device__ __forceinline__ void gemm_phase(PG8_LAS unsigned char* lds, const Sched& S, const Epi& E, const AM& am) {
    int tid = threadIdx.x; asm volatile("" : "+v"(tid));
    const int wid = __builtin_amdgcn_readfirstlane(tid >> 6), lane = tid & 63, wr = wid >> 2, wc = wid & 3, fr = lane & 15, fq = lane >> 4;
    constexpr int K = KD, nt = K / BK;
    int sR[2], sC[2]; unsigned voffB[2][2];
#pragma unroll
    for (int i = 0; i < 2; ++i) { stage_rc(tid * 16 + i * 8192, sR[i], sC[i]); const int Rb = Epi::PERM ? ((sR[i] & ~31) + perm32(sR[i] & 31)) : sR[i];
        voffB[0][i] = (unsigned)(Rb * K + sC[i]) * 2u; voffB[1][i] = voffB[0][i] + (unsigned)(HALF * K * 2); }
    const size_t kstep = (size_t)(BK * 2);
    const unsigned ldsw = (unsigned)wid * 1024u;
    const int aoff = lds_byte(wr * 64 + fr, fq * 8), boff = lds_byte(wc * 32 + fr, fq * 8);
#define PG8_SA(b, h) (((b) * 2 + (h)) * HTB)
#define PG8_SB(b, h) ((4 + (b) * 2 + (h)) * HTB)
#define PG8_STAGE(bufoff, gbase, voff) do { _Pragma("unroll") for (int _i = 0; _i < 2; ++_i) \
        __builtin_amdgcn_global_load_lds((const unsigned*)((const char*)(gbase) + (voff)[_i]), (PG8_LAS unsigned*)(lds + (bufoff) + ldsw + _i * 8192), 16, 0, 0); } while (0)
#define PG8_LDA(dst, b, h) do { _Pragma("unroll") for (int m = 0; m < 4; ++m) _Pragma("unroll") for (int k = 0; k < 2; ++k) dst[m][k] = *(const PG8_LAS bf16x8*)(lds + PG8_SA(b, h) + aoff + m * 2048 + k * 1024); } while (0)
#define PG8_LDB(dst, b, h) do { _Pragma("unroll") for (int n = 0; n < 2; ++n) _Pragma("unroll") for (int k = 0; k < 2; ++k) dst[n][k] = *(const PG8_LAS bf16x8*)(lds + PG8_SB(b, h) + boff + n * 2048 + k * 1024); } while (0)
#define PG8_MMA(ai, bj, At, Bt) do { __builtin_amdgcn_s_setprio(1); _Pragma("unroll") for (int m = 0; m < 4; ++m) _Pragma("unroll") for (int n = 0; n < 2; ++n) _Pragma("unroll") for (int k = 0; k < 2; ++k) \
        acc[ai][bj][m][n] = __builtin_amdgcn_mfma_f32_16x16x32_bf16(Bt[n][k], At[m][k], acc[ai][bj][m][n], 0, 0, 0); __builtin_amdgcn_s_setprio(0); } while (0)
#define PG8_WAIT_V(n) asm volatile("s_waitcnt vmcnt(" #n ")" ::: "memory")
#define PG8_WAIT_L(n) asm volatile("s_waitcnt lgkmcnt(" #n ")" ::: "memory")
#define PG8_BAR __builtin_amdgcn_s_barrier()
#define PG8_SCHED __builtin_amdgcn_sched_barrier(0)
    Unit cur, nxt; int ui = 0;
    if (!S.next(0, cur)) return;
    f32x4 acc[2][2][4][2];
#pragma unroll
    for (int a = 0; a < 2; ++a)
#pragma unroll
        for (int b = 0; b < 2; ++b)
#pragma unroll
            for (int m = 0; m < 4; ++m)
#pragma unroll
                for (int n = 0; n < 2; ++n) acc[a][b][m][n] = (f32x4){0.f, 0.f, 0.f, 0.f};
    bf16x8 At[4][2], B0[2][2], B1[2][2];
    unsigned vAc[2][2], vAn[2][2];
    am.a_offs(cur, sR, sC, vAc);
    const char* cA = am.a_base(cur); const char* cB = am.b_base(cur);
    if constexpr (SP2) {
        PG8_STAGE(PG8_SB(0, 0), cB, voffB[0]); PG8_STAGE(PG8_SB(0, 1), cB, voffB[1]); PG8_STAGE(PG8_SA(0, 0), cA, vAc[0]); PG8_STAGE(PG8_SA(0, 1), cA, vAc[1]);
        if (wr == 1) PG8_BAR;
        PG8_WAIT_V(2); PG8_BAR;
        PG8_STAGE(PG8_SB(1, 0), cB + kstep, voffB[0]); PG8_STAGE(PG8_SA(1, 0), cA + kstep, vAc[0]); PG8_STAGE(PG8_SB(1, 1), cB + kstep, voffB[1]);
        PG8_WAIT_V(6); PG8_BAR;
    } else {
        PG8_STAGE(PG8_SB(0, 0), cB, voffB[0]); PG8_STAGE(PG8_SA(0, 0), cA, vAc[0]); PG8_STAGE(PG8_SB(0, 1), cB, voffB[1]); PG8_STAGE(PG8_SA(0, 1), cA, vAc[1]);
        if (wr == 1) PG8_BAR;
        PG8_WAIT_V(4); PG8_BAR;
        PG8_STAGE(PG8_SB(1, 0), cB + kstep, voffB[0]); PG8_STAGE(PG8_SA(1, 0), cA + kstep, vAc[0]); PG8_STAGE(PG8_SB(1, 1), cB + kstep, voffB[1]);
        PG8_WAIT_V(6); PG8_BAR;
    }
    for (;;) {
        const bool has_next = S.next(ui + 1, nxt);
        const char* nA = cA; const char* nB = cB;
#pragma unroll
        for (int h = 0; h < 2; ++h)
#pragma unroll
            for (int i = 0; i < 2; ++i) vAn[h][i] = vAc[h][i];
        if (has_next) { nA = am.a_base(nxt); nB = am.b_base(nxt); am.a_offs(nxt, sR, sC, vAn); }
        for (int t = 0; t < nt; t += 2) {
            const bool last = (t == nt - 2);
            const char* a1 = cA + (size_t)(t + 1) * kstep;
            const char* a2 = last ? nA : cA + (size_t)(t + 2) * kstep; const char* b2 = last ? nB : cB + (size_t)(t + 2) * kstep;
            const char* a3 = a2 + kstep; const char* b3 = b2 + kstep;
            unsigned vA2[2][2];
#pragma unroll
            for (int h = 0; h < 2; ++h)
#pragma unroll
                for (int i = 0; i < 2; ++i) vA2[h][i] = last ? vAn[h][i] : vAc[h][i];
            if constexpr (SP2) {
            PG8_LDB(B0, 0, 0); PG8_LDB(B1, 0, 1); PG8_SCHED; PG8_LDA(At, 0, 0); PG8_STAGE(PG8_SA(1, 1), a1, vAc[1]);
            PG8_WAIT_V(8); PG8_WAIT_L(0); PG8_BAR; PG8_MMA(0, 0, At, B0); PG8_MMA(0, 1, At, B1); PG8_BAR; PG8_SCHED;
            PG8_LDA(At, 0, 1); PG8_STAGE(PG8_SB(0, 0), b2, voffB[0]); PG8_STAGE(PG8_SB(0, 1), b2, voffB[1]); PG8_STAGE(PG8_SA(0, 0), a2, vA2[0]);
            PG8_WAIT_V(8); PG8_WAIT_L(0); PG8_BAR; PG8_MMA(1, 0, At, B0); PG8_MMA(1, 1, At, B1); PG8_BAR; PG8_SCHED;
            PG8_LDB(B0, 1, 0); PG8_LDB(B1, 1, 1); PG8_SCHED; PG8_LDA(At, 1, 0); PG8_STAGE(PG8_SA(0, 1), a2, vA2[1]);
            PG8_WAIT_V(8); PG8_WAIT_L(0); PG8_BAR; PG8_MMA(0, 0, At, B0); PG8_MMA(0, 1, At, B1); PG8_BAR; PG8_SCHED;
            PG8_LDA(At, 1, 1); PG8_STAGE(PG8_SB(1, 0), b3, voffB[0]); PG8_STAGE(PG8_SB(1, 1), b3, voffB[1]); PG8_STAGE(PG8_SA(1, 0), a3, vA2[0]);
            PG8_WAIT_V(8); PG8_WAIT_L(0); PG8_BAR; PG8_MMA(1, 0, At, B0); PG8_MMA(1, 1, At, B1); PG8_BAR; PG8_SCHED;
            } else {
            PG8_LDB(B0, 0, 0); PG8_SCHED; PG8_LDA(At, 0, 0); PG8_STAGE(PG8_SA(1, 1), a1, vAc[1]);
            PG8_WAIT_L(8); PG8_BAR; PG8_WAIT_L(0); PG8_MMA(0, 0, At, B0); PG8_BAR; PG8_SCHED;
            PG8_LDB(B1, 0, 1); PG8_STAGE(PG8_SB(0, 0), b2, voffB[0]);
            PG8_BAR; PG8_WAIT_L(0); PG8_MMA(0, 1, At, B1); PG8_BAR;
            PG8_LDA(At, 0, 1); PG8_STAGE(PG8_SA(0, 0), a2, vA2[0]);
            PG8_BAR; PG8_WAIT_L(0); PG8_MMA(1, 0, At, B0); PG8_BAR; PG8_SCHED;
            PG8_STAGE(PG8_SB(0, 1), b2, voffB[1]);
            PG8_WAIT_V(6); PG8_BAR; PG8_MMA(1, 1, At, B1); PG8_BAR;
            PG8_LDB(B0, 1, 0); PG8_SCHED; PG8_LDA(At, 1, 0); PG8_STAGE(PG8_SA(0, 1), a2, vA2[1]);
            PG8_WAIT_L(8); PG8_BAR; PG8_WAIT_L(0); PG8_MMA(0, 0, At, B0); PG8_BAR; PG8_SCHED;
            PG8_LDB(B1, 1, 1); PG8_STAGE(PG8_SB(1, 0), b3, voffB[0]);
            PG8_BAR; PG8_WAIT_L(0); PG8_MMA(0, 1, At, B1); PG8_BAR;
            PG8_LDA(At, 1, 1); PG8_STAGE(PG8_SA(1, 0), a3, vA2[0]);
            PG8_BAR; PG8_WAIT_L(0); PG8_MMA(1, 0, At, B0); PG8_BAR; PG8_SCHED;
            PG8_STAGE(PG8_SB(1, 1), b3, voffB[1]);
            PG8_WAIT_V(6); PG8_BAR; PG8_MMA(1, 1, At, B1); PG8_BAR;
            }
        }
        if constexpr (ALIGN_EPI) { if (wr == 0) PG8_BAR; }
        { int fr2 = fr, fq2 = fq; asm volatile("" : "+v"(fr2), "+v"(fq2)); E(acc, cur, wr, wc, fr2, fq2); }
        if (!has_next) break;
#pragma unroll
        for (int a = 0; a < 2; ++a)
#pragma unroll
            for (int b = 0; b < 2; ++b)
#pragma unroll
                for (int m = 0; m < 4; ++m)
#pragma unroll
                    for (int n = 0; n < 2; ++n) acc[a][b][m][n] = (f32x4){0.f, 0.f, 0.f, 0.f};
        cur = nxt; cA = nA; cB = nB; ++ui;
#pragma unroll
        for (int h = 0; h < 2; ++h)
#pragma unroll
            for (int i = 0; i < 2; ++i) vAc[h][i] = vAn[h][i];
        if constexpr (ALIGN_EPI) { if (wr == 1) PG8_BAR; }
    }
    PG8_WAIT_V(0);
    if constexpr (!ALIGN_EPI) { if (wr == 0) PG8_BAR; }
    PG8_BAR;
#undef PG8_SA
#undef PG8_SB
#undef PG8_STAGE
#undef PG8_LDA
#undef PG8_LDB
#undef PG8_MMA
#undef PG8_WAIT_V
#undef PG8_WAIT_L
#undef PG8_BAR
#undef PG8_SCHED
}

typedef int i32x8 __attribute__((ext_vector_type(8)));
constexpr int RSB8 = 1024, NT8 = 8;
__host__ __device__ __forceinline__ int f8swz(int rr) { return ((rr >> 1) & 1) ^ (((rr >> 3) & 1) << 2); }
struct MoeGuAB8 { const unsigned char* A; const unsigned char* Bt; const int* list; const PG8_LAS int* tp; const PG8_LAS int* cnt;
    __device__ __forceinline__ const char* a_base(const Unit&) const { return (const char*)A; }
    __device__ __forceinline__ const char* b_base(const Unit& u) const { return (const char*)Bt + (size_t)u.e * (2048 * RSB8) + (size_t)u.pn * (BM * RSB8); }
    __device__ __forceinline__ void a_offs(const Unit& u, const int (&R)[2], const int (&Cb)[2], unsigned (&v)[2][2]) const {
        const int r0 = (u.pm - tp[u.e]) * BM, n = cnt[u.e];
#pragma unroll
        for (int h = 0; h < 2; ++h)
#pragma unroll
            for (int i = 0; i < 2; ++i) { const int rank = r0 + h * HALF + R[i]; int tok = list[(size_t)u.e * CAP + rank]; tok = rank < n ? tok : 0;
                v[h][i] = (unsigned)(tok * RSB8 + Cb[i]); } }
};
struct DenseAB8 { const unsigned char* A; const unsigned char* Bt;
    __device__ __forceinline__ const char* a_base(const Unit& u) const { return (const char*)A + (size_t)u.pm * (BM * RSB8); }
    __device__ __forceinline__ const char* b_base(const Unit& u) const { return (const char*)Bt + (size_t)u.pn * (BM * RSB8); }
    __device__ __forceinline__ void a_offs(const Unit&, const int (&R)[2], const int (&Cb)[2], unsigned (&v)[2][2]) const {
#pragma unroll
        for (int h = 0; h < 2; ++h)
#pragma unroll
            for (int i = 0; i < 2; ++i) v[h][i] = (unsigned)((h * HALF + R[i]) * RSB8 + Cb[i]); }
};
struct MoeDnAB8 { const unsigned char* A; const unsigned char* Bt;
    __device__ __forceinline__ const char* a_base(const Unit& u) const { return (const char*)A + (size_t)u.pm * (BM * RSB8); }
    __device__ __forceinline__ const char* b_base(const Unit& u) const { return (const char*)Bt + (size_t)u.e * (1024 * RSB8) + (size_t)u.pn * (BM * RSB8); }
    __device__ __forceinline__ void a_offs(const Unit&, const int (&R)[2], const int (&Cb)[2], unsigned (&v)[2][2]) const {
#pragma unroll
        for (int h = 0; h < 2; ++h)
#pragma unroll
            for (int i = 0; i < 2; ++i) v[h][i] = (unsigned)((h * HALF + R[i]) * RSB8 + Cb[i]); }
};
__device__ __forceinline__ unsigned pk4_fp8(float a, float b, float c, float d) { int w = __builtin_amdgcn_cvt_pk_fp8_f32(a, b, 0, false); w = __builtin_amdgcn_cvt_pk_fp8_f32(c, d, w, true); return (unsigned)w; }
struct EpiGU8 {
    static constexpr bool PERM = true;
    unsigned char* ACT; const float* bgu;
    __device__ __forceinline__ void operator()(const f32x4 (&acc)[2][2][4][2], const Unit& u, int wr, int wc, int fr, int fq) const {
        const int row0 = u.pm * BM + wr * 64 + fr, j0 = u.pn * HALF + wc * 32 + 8 * fq;
        const float* bg = bgu + (size_t)u.e * 2048 + j0;
        f32x4 bgv[2], buv[2];
#pragma unroll
        for (int n = 0; n < 2; ++n) { bgv[n] = *(const f32x4*)(bg + 4 * n); buv[n] = *(const f32x4*)(bg + 1024 + 4 * n) + 1.0f; }
        const int jw = u.pn * HALF + wc * 32 + 16 * (fq >> 1);
#pragma unroll
        for (int ai = 0; ai < 2; ++ai) { u32x2 wv[4];
#pragma unroll
            for (int m = 0; m < 4; ++m) { float a[8];
#pragma unroll
                for (int n = 0; n < 2; ++n)
#pragma unroll
                    for (int i = 0; i < 4; ++i) { float g = acc[ai][0][m][n][i] * (1.0f / 32.0f) + bgv[n][i], u1 = acc[ai][1][m][n][i] * (1.0f / 32.0f) + buv[n][i];
                        g = fminf(g, 7.0f); u1 = __builtin_amdgcn_fmed3f(u1, -6.0f, 8.0f);
                        const float sg_ = __builtin_amdgcn_rcpf(1.0f + __builtin_amdgcn_exp2f(g * (-1.702f * 1.4426950408889634f)));
                        a[n * 4 + i] = u1 * g * sg_; }
                wv[m].x = pk4_fp8(a[0], a[1], a[2], a[3]); wv[m].y = pk4_fp8(a[4], a[5], a[6], a[7]);
                if (m & 1) {
                    const auto sx = __builtin_amdgcn_permlane16_swap(wv[m - 1].x, wv[m].x, false, false); const auto sy = __builtin_amdgcn_permlane16_swap(wv[m - 1].y, wv[m].y, false, false);
                    *(u32x4*)(ACT + (size_t)(row0 + ai * HALF + (m - 1 + (fq & 1)) * 16) * 1024 + jw) = (u32x4){sx[0], sy[0], sx[1], sy[1]}; } } }
    }
};
struct EpiDn8 {
    static constexpr bool PERM = true;
    bf16_t* O; const float* bias;
    __device__ __forceinline__ void operator()(const f32x4 (&acc)[2][2][4][2], const Unit& u, int wr, int wc, int fr, int fq) const {
        const int row0 = u.pm * BM + wr * 64 + fr, col0 = u.pn * BM + wc * 32 + 8 * fq;
        f32x4 bv[2][2];
#pragma unroll
        for (int bj = 0; bj < 2; ++bj)
#pragma unroll
            for (int n = 0; n < 2; ++n) bv[bj][n] = *(const f32x4*)(bias + (size_t)u.e * 1024 + col0 + bj * HALF + 4 * n);
        const int cw = u.pn * BM + wc * 32 + 16 * (fq >> 1);
#pragma unroll
        for (int ai = 0; ai < 2; ++ai) { u32x2 wv[4][2];
#pragma unroll
            for (int m = 0; m < 4; ++m) {
#pragma unroll
                for (int bj = 0; bj < 2; ++bj) { const f32x4 v0 = acc[ai][bj][m][0] * (1.0f / 64.0f) + bv[bj][0], v1 = acc[ai][bj][m][1] * (1.0f / 64.0f) + bv[bj][1];
                    wv[m][bj].x = pk4_fp8(v0[0], v0[1], v0[2], v0[3]); wv[m][bj].y = pk4_fp8(v1[0], v1[1], v1[2], v1[3]);
                    if (m & 1) {
                        const auto sx = __builtin_amdgcn_permlane16_swap(wv[m - 1][bj].x, wv[m][bj].x, false, false); const auto sy = __builtin_amdgcn_permlane16_swap(wv[m - 1][bj].y, wv[m][bj].y, false, false);
                        *(u32x4*)((unsigned char*)O + (size_t)(row0 + ai * HALF + (m - 1 + (fq & 1)) * 16) * 1024 + cw + bj * HALF) = (u32x4){sx[0], sy[0], sx[1], sy[1]}; } } } }
    }
};
template <class Epi, class Sched, class AM>
__device__ __forceinline__ void gemm_phase_f8(PG8_LAS unsigned char* lds, const Sched& S, const Epi& E, const AM& am) {
    int tid = threadIdx.x; asm volatile("" : "+v"(tid));
    const int wid = __builtin_amdgcn_readfirstlane(tid >> 6), lane = tid & 63, wr = wid >> 2, wc = wid & 3, fr = lane & 15, fq = lane >> 4;
    constexpr int nt = NT8;
#define PG8_GEOM(sR, sCb) int sR[2], sCb[2]; { int l_ = threadIdx.x & 63; asm volatile("" : "+v"(l_)); _Pragma("unroll") for (int i = 0; i < 2; ++i) { sR[i] = (wid + 8 * i) * 8 + (l_ >> 3); sCb[i] = ((l_ & 7) ^ f8swz(sR[i] & 15)) * 16; } }
#define PG8_VOFFB(v, h) unsigned v[2]; { PG8_GEOM(r_, c_); _Pragma("unroll") for (int i = 0; i < 2; ++i) { const int Rb_ = Epi::PERM ? ((r_[i] & ~31) + perm32(r_[i] & 31)) : r_[i]; v[i] = (unsigned)(((h) * HALF + Rb_) * RSB8 + c_[i]); } }
    const size_t kstep = 128;
    const unsigned ldsw = (unsigned)wid * 1024u;
    const int aoff0 = (wr * 64 + fr) * 128 + ((2 * fq) ^ f8swz(fr)) * 16, boff0 = (wc * 32 + fr) * 128 + ((2 * fq) ^ f8swz(fr)) * 16;
#define PG8_SA(b, h) (((b) * 2 + (h)) * HTB)
#define PG8_SB(b, h) ((4 + (b) * 2 + (h)) * HTB)
#define PG8_STAGE(bufoff, gbase, voff) do { _Pragma("unroll") for (int _i = 0; _i < 2; ++_i) \
        __builtin_amdgcn_global_load_lds((const unsigned*)((const char*)(gbase) + (voff)[_i]), (PG8_LAS unsigned*)(lds + (bufoff) + ldsw + _i * 8192), 16, 0, 0); } while (0)
#define PG8_LD2(dst, off0, off1) do { const u32x4 lo_ = *(const PG8_LAS u32x4*)(lds + (off0)), hi_ = *(const PG8_LAS u32x4*)(lds + (off1)); dst = (i32x8){(int)lo_.x, (int)lo_.y, (int)lo_.z, (int)lo_.w, (int)hi_.x, (int)hi_.y, (int)hi_.z, (int)hi_.w}; } while (0)
#define PG8_LDA(dst, b, h) do { _Pragma("unroll") for (int m = 0; m < 4; ++m) PG8_LD2(dst[m], PG8_SA(b, h) + aoff0 + m * 2048, PG8_SA(b, h) + (aoff0 ^ 16) + m * 2048); } while (0)
#define PG8_LDB(dst, b, h) do { _Pragma("unroll") for (int n = 0; n < 2; ++n) PG8_LD2(dst[n], PG8_SB(b, h) + boff0 + n * 2048, PG8_SB(b, h) + (boff0 ^ 16) + n * 2048); } while (0)
#define PG8_MMA(ai, bj, At, Bt) do { __builtin_amdgcn_s_setprio(1); asm volatile("s_nop 1" ::: "memory"); _Pragma("unroll") for (int m = 0; m < 4; ++m) _Pragma("unroll") for (int n = 0; n < 2; ++n) \
        asm volatile("v_mfma_scale_f32_16x16x128_f8f6f4 %0, %1, %2, %0, %3, %3 op_sel_hi:[0,0,0]" : "+v"(acc[ai][bj][m][n]) : "v"(Bt[n]), "v"(At[m]), "v"(scale1)); __builtin_amdgcn_s_setprio(0); } while (0)
#define PG8_WAIT_V(n) asm volatile("s_waitcnt vmcnt(" #n ")" ::: "memory")
#define PG8_WAIT_L(n) asm volatile("s_waitcnt lgkmcnt(" #n ")" ::: "memory")
#define PG8_BAR __builtin_amdgcn_s_barrier()
#define PG8_SCHED __builtin_amdgcn_sched_barrier(0)
    const int scale1 = 0x7f7f7f7f;
    Unit cur, nxt; int ui = 0;
    if (!S.next(0, cur)) return;
    f32x4 acc[2][2][4][2];
#pragma unroll
    for (int a = 0; a < 2; ++a)
#pragma unroll
        for (int b = 0; b < 2; ++b)
#pragma unroll
            for (int m = 0; m < 4; ++m)
#pragma unroll
                for (int n = 0; n < 2; ++n) acc[a][b][m][n] = (f32x4){0.f, 0.f, 0.f, 0.f};
    i32x8 At[4], B0[2], B1[2];
    unsigned vAc[2][2], vAn[2][2];
    { PG8_GEOM(sR, sCb); am.a_offs(cur, sR, sCb, vAc); }
    const char* cA = am.a_base(cur); const char* cB = am.b_base(cur);
    { PG8_VOFFB(vb0_, 0); PG8_STAGE(PG8_SB(0, 0), cB, vb0_); } { PG8_VOFFB(vb1_, 1); PG8_STAGE(PG8_SB(0, 1), cB, vb1_); } PG8_STAGE(PG8_SA(0, 0), cA, vAc[0]); PG8_STAGE(PG8_SA(0, 1), cA, vAc[1]);
    if (wr == 1) PG8_BAR;
    PG8_WAIT_V(2); PG8_BAR;
    { PG8_VOFFB(vb0_, 0); PG8_STAGE(PG8_SB(1, 0), cB + kstep, vb0_); } PG8_STAGE(PG8_SA(1, 0), cA + kstep, vAc[0]); { PG8_VOFFB(vb1_, 1); PG8_STAGE(PG8_SB(1, 1), cB + kstep, vb1_); }
    PG8_WAIT_V(6); PG8_BAR;
    for (;;) {
        const bool has_next = S.next(ui + 1, nxt);
        const char* nA = cA; const char* nB = cB;
#pragma unroll
        for (int h = 0; h < 2; ++h)
#pragma unroll
            for (int i = 0; i < 2; ++i) vAn[h][i] = vAc[h][i];
        if (has_next) { nA = am.a_base(nxt); nB = am.b_base(nxt); PG8_GEOM(sR, sCb); am.a_offs(nxt, sR, sCb, vAn); }
#pragma unroll 1
        for (int t = 0; t < nt; t += 2) {
            const bool last = (t == nt - 2);
            const char* a1 = cA + (size_t)(t + 1) * kstep;
            const char* a2 = last ? nA : cA + (size_t)(t + 2) * kstep; const char* b2 = last ? nB : cB + (size_t)(t + 2) * kstep;
            const char* a3 = a2 + kstep; const char* b3 = b2 + kstep;
            PG8_LDB(B0, 0, 0); PG8_LDB(B1, 0, 1); PG8_SCHED; PG8_LDA(At, 0, 0); PG8_STAGE(PG8_SA(1, 1), a1, vAc[1]);
            if (last) {
#pragma unroll
                for (int h = 0; h < 2; ++h)
#pragma unroll
                    for (int i = 0; i < 2; ++i) vAc[h][i] = vAn[h][i]; }
            PG8_WAIT_V(8); PG8_WAIT_L(0); PG8_BAR; PG8_MMA(0, 0, At, B0); PG8_MMA(0, 1, At, B1); PG8_BAR; PG8_SCHED;
            PG8_LDA(At, 0, 1); { PG8_VOFFB(vb0_, 0); PG8_STAGE(PG8_SB(0, 0), b2, vb0_); } { PG8_VOFFB(vb1_, 1); PG8_STAGE(PG8_SB(0, 1), b2, vb1_); } PG8_STAGE(PG8_SA(0, 0), a2, vAc[0]);
            PG8_WAIT_V(8); PG8_WAIT_L(0); PG8_BAR; PG8_MMA(1, 0, At, B0); PG8_MMA(1, 1, At, B1); PG8_BAR; PG8_SCHED;
            PG8_LDB(B0, 1, 0); PG8_LDB(B1, 1, 1); PG8_SCHED; PG8_LDA(At, 1, 0); PG8_STAGE(PG8_SA(0, 1), a2, vAc[1]);
            PG8_WAIT_V(8); PG8_WAIT_L(0); PG8_BAR; PG8_MMA(0, 0, At, B0); PG8_MMA(0, 1, At, B1); PG8_BAR; PG8_SCHED;
            PG8_LDA(At, 1, 1); { PG8_VOFFB(vb0_, 0); PG8_STAGE(PG8_SB(1, 0), b3, vb0_); } { PG8_VOFFB(vb1_, 1); PG8_STAGE(PG8_SB(1, 1), b3, vb1_); } PG8_STAGE(PG8_SA(1, 0), a3, vAc[0]);
            PG8_WAIT_V(8); PG8_WAIT_L(0); PG8_BAR; PG8_MMA(1, 0, At, B0); PG8_MMA(1, 1, At, B1); PG8_BAR; PG8_SCHED;
        }
        if (wr == 0) PG8_BAR;
        asm volatile("s_nop 15\n\ts_nop 15\n\ts_nop 15" ::: "memory");
        { int l2 = threadIdx.x & 63; asm volatile("" : "+v"(l2)); E(acc, cur, wr, wc, l2 & 15, l2 >> 4); }
        if (!has_next) break;
#pragma unroll
        for (int a = 0; a < 2; ++a)
#pragma unroll
            for (int b = 0; b < 2; ++b)
#pragma unroll
                for (int m = 0; m < 4; ++m)
#pragma unroll
                    for (int n = 0; n < 2; ++n) acc[a][b][m][n] = (f32x4){0.f, 0.f, 0.f, 0.f};
        cur = nxt; cA = nA; cB = nB; ++ui;
        if (wr == 1) PG8_BAR;
    }
    PG8_WAIT_V(0);
    PG8_BAR;
#undef PG8_SA
#undef PG8_SB
#undef PG8_STAGE
#undef PG8_LD2
#undef PG8_LDA
#undef PG8_LDB
#undef PG8_MMA
#undef PG8_WAIT_V
#undef PG8_WAIT_L
#undef PG8_BAR
#undef PG8_GEOM
#undef PG8_VOFFB
#undef PG8_SCHED
}
}

#define XB_TMO      128
#define XB_XCNT(j)  (256  + 64 * (j))
#define XB_XSUB(j)  (1280 + 64 * (j))
#define XB_XGEN(j)  (2304 + 64 * (j))
#define XB_TOP      3328
#define XB_TOPGEN   3392
#define XCD_BAR_WORDS 3456
#define XB_SPIN_CAP (1u << 18)
__device__ __forceinline__ unsigned xb_ld(unsigned* p)              { return __hip_atomic_load(p, __ATOMIC_RELAXED, __HIP_MEMORY_SCOPE_AGENT); }
__device__ __forceinline__ unsigned xb_add(unsigned* p, unsigned v) { return __hip_atomic_fetch_add(p, v, __ATOMIC_RELAXED, __HIP_MEMORY_SCOPE_AGENT); }
__device__ __forceinline__ unsigned xb_xcc_id() { return (unsigned)__builtin_amdgcn_s_getreg((3 << 11) | 20) & 0xFu; }
#define XB_SPIN(cond, bar) do { unsigned _sp = 0; while (cond) { __builtin_amdgcn_s_sleep(1); \
    if ((++_sp & 255u) == 0u) { if (xb_ld(&(bar)[XB_TMO])) break; if (_sp > XB_SPIN_CAP) { atomicAdd(&(bar)[XB_TMO], 1u); break; } } } } while (0)
struct XcdBarrier { unsigned* bar; unsigned x; volatile LAS unsigned* st; };
__device__ __forceinline__ XcdBarrier xcd_barrier_post(unsigned* bar, volatile LAS unsigned* st) {
    XcdBarrier b; b.bar = bar; b.x = xb_xcc_id(); b.st = st;
    if (threadIdx.x == 0) (void)xb_add(&bar[XB_XCNT(b.x)], 1u);
    return b;
}
__device__ __forceinline__ void xcd_barrier_complete(unsigned* bar, unsigned x, unsigned& nloc, unsigned& nx) {
    const unsigned G = gridDim.x * gridDim.y * gridDim.z;
    unsigned sum, cnt, mine, sp = 0u;
    for (;;) {
        sum = 0u; cnt = 0u; mine = 0u;
#pragma unroll
        for (unsigned j = 0; j < 16; ++j) { const unsigned c = xb_ld(&bar[XB_XCNT(j)]); sum += c; cnt += (c > 0u) ? 1u : 0u; mine = (j == x) ? c : mine; }
        if (sum == G) break;
        __builtin_amdgcn_s_sleep(1);
        if ((++sp & 255u) == 0u) { if (xb_ld(&bar[XB_TMO])) break; if (sp > XB_SPIN_CAP) { atomicAdd(&bar[XB_TMO], 1u); break; } }
    }
    nloc = mine > 0u ? mine : 1u; nx = cnt > 0u ? cnt : 1u;
}
__device__ __forceinline__ void xcd_barrier(const XcdBarrier& b) {
    asm volatile("s_waitcnt vmcnt(0)" ::: "memory");
    __syncthreads();
    if (threadIdx.x == 0) {
        unsigned* bar = b.bar;
        __builtin_amdgcn_s_waitcnt(0);
        unsigned nloc = b.st[0], nx = b.st[1];
        if (nloc == 0u) { xcd_barrier_complete(bar, b.x, nloc, nx); b.st[0] = nloc; b.st[1] = nx; }
        const unsigned old = xb_add(&bar[XB_XSUB(b.x)], 1u);
        const unsigned gen = old / nloc;
        if (old + 1u == (gen + 1u) * nloc) {
            __builtin_amdgcn_fence(__ATOMIC_RELEASE, "agent");
            asm volatile("s_waitcnt vmcnt(0)" ::: "memory");
            const unsigned og = xb_add(&bar[XB_TOP], 1u);
            const unsigned tg = og / nx;
            if (og + 1u == (tg + 1u) * nx) xb_add(&bar[XB_TOPGEN], 1u);
            else XB_SPIN(xb_ld(&bar[XB_TOPGEN]) == tg, bar);
            __builtin_amdgcn_fence(__ATOMIC_ACQUIRE, "agent");
            xb_add(&bar[XB_XGEN(b.x)], 1u);
            asm volatile("s_waitcnt vmcnt(0)" ::: "memory");
        } else {
            XB_SPIN(xb_ld(&bar[XB_XGEN(b.x)]) == gen, bar);
            __builtin_amdgcn_fence(__ATOMIC_ACQUIRE, "agent");
            asm volatile("s_waitcnt vmcnt(0)" ::: "memory");
        }
    }
    __syncthreads();
}


namespace attn {
typedef int i32x8 __attribute__((ext_vector_type(8)));
typedef float f32x16 __attribute__((ext_vector_type(16)));
constexpr int SLOT = 16384, NT = (SEQ + CTXL) / 64, NUNITS = NB * 8 * (SEQ / 128), VT_TILE = 8192;
constexpr float THR = 6.0f;
#define AT_SB() __builtin_amdgcn_sched_barrier(0)
__device__ __forceinline__ float max3f(float a, float b, float c) { float r; asm("v_max3_f32 %0, %1, %2, %3" : "=v"(r) : "v"(a), "v"(b), "v"(c)); return r; }
__device__ __forceinline__ float rowmax32(const f32x16& a, const f32x16& b) { float m0 = max3f(a[0], a[1], b[0]), m1 = max3f(a[2], a[3], b[1]); m0 = max3f(m0, b[2], b[3]);
#pragma unroll
    for (int i = 4; i < 16; i += 4) { m0 = max3f(m0, a[i], a[i + 1]); m1 = max3f(m1, a[i + 2], a[i + 3]); m0 = max3f(m0, b[i], b[i + 1]); m1 = max3f(m1, b[i + 2], b[i + 3]); }
    float m; asm("v_max_f32_e32 %0, %1, %2" : "=v"(m) : "v"(m0), "v"(m1)); return m; }
__device__ __forceinline__ int crow(int i, int h) { return (i & 3) + 8 * (i >> 2) + 4 * h; }
__device__ __forceinline__ void vtile(const u16* __restrict__ VBw, unsigned char* __restrict__ VT8, int G, int bx) {
    const unsigned char* VB = (const unsigned char*)VBw;
    int tid = threadIdx.x; asm volatile("" : "+v"(tid));
    const int dq = tid & 31, cc = (tid >> 5) & 3, h = cc >> 1, jh = cc & 1;
    for (int it = bx * 4 + (tid >> 7); it < NB * 8 * NT; it += G * 4) {
        const int bh = it / NT, t = it - bh * NT, b = bh >> 3, hh = bh & 7;
        const size_t rowbase = t < 128 ? (size_t)b * SEQ + 64 * t : (size_t)TL + (size_t)b * CTXL + 64 * (t - 128);
        const unsigned char* src = VB + rowbase * D + hh * 128 + 4 * dq;
        unsigned w[16];
#pragma unroll
        for (int i = 0; i < 16; ++i) w[i] = __builtin_nontemporal_load((const unsigned*)(src + (size_t)(32 * jh + crow(i, h)) * D));
        unsigned o[4][4];
#pragma unroll
        for (int g = 0; g < 4; ++g) { const unsigned w0 = w[4 * g], w1 = w[4 * g + 1], w2 = w[4 * g + 2], w3 = w[4 * g + 3];
            const unsigned l01 = __builtin_amdgcn_perm(w1, w0, 0x05010400u), h01 = __builtin_amdgcn_perm(w1, w0, 0x07030602u), l23 = __builtin_amdgcn_perm(w3, w2, 0x05010400u), h23 = __builtin_amdgcn_perm(w3, w2, 0x07030602u);
            o[0][g] = __builtin_amdgcn_perm(l23, l01, 0x05040100u); o[1][g] = __builtin_amdgcn_perm(l23, l01, 0x07060302u); o[2][g] = __builtin_amdgcn_perm(h23, h01, 0x05040100u); o[3][g] = __builtin_amdgcn_perm(h23, h01, 0x07060302u); }
        unsigned char* dst = VT8 + ((size_t)bh * NT + t) * VT_TILE + (size_t)(4 * dq) * 64 + ((cc ^ (dq & 3)) << 4);
#pragma unroll
        for (int bq = 0; bq < 4; ++bq) *(v4u*)(dst + bq * 64) = (v4u){o[bq][0], o[bq][1], o[bq][2], o[bq][3]};
    }
}
__device__ __forceinline__ void phase(LAS unsigned char* lds, const unsigned char* __restrict__ QK8, const unsigned char* __restrict__ VT8, u16* __restrict__ O, const float* __restrict__ tab, const float* __restrict__ norm_g, int G, int bx) {
    int tid = threadIdx.x; asm volatile("" : "+v"(tid));
    const int wave = __builtin_amdgcn_readfirstlane(tid >> 6), lane = tid & 63, r = lane & 31, h = lane >> 5, mp = wave >> 2, qs = wave & 3;
    const int vcu = (G % 8 == 0) ? (bx % 8) * (G / 8) + bx / 8 : bx;
    const int scale1 = 0x7f7f7f7f;
    const int koff = r * 128 + (((4 * mp + 2 * h) ^ ((r >> 1) & 7)) << 4);
    const int voff = 8192 + r * 64 + (((2 * h) ^ ((r >> 2) & 3)) << 4);
#define AT_LD32(dst, p0) do { const v4u lo_ = *(const LAS v4u*)(p0), hi_ = *(const LAS v4u*)((const LAS unsigned char*)(lds) + ((int)((p0) - (const LAS unsigned char*)(lds)) ^ 16)); \
        dst = (i32x8){(int)lo_.x, (int)lo_.y, (int)lo_.z, (int)lo_.w, (int)hi_.x, (int)hi_.y, (int)hi_.z, (int)hi_.w}; } while (0)
    for (int uu = vcu, it = 0; uu < NUNITS; uu += G, ++it) {
        const int u = (G == 256) ? ((8 * (it >> 1) + (bx & 7)) << 6) + 32 * (it & 1) + (bx >> 3) : uu;
        const int bh = u >> 6, qb = u & 63, b = bh >> 3, hh = bh & 7;
        const size_t qrow = (size_t)b * SEQ + qb * 128 + qs * 32 + r;
        i32x8 qf; { const v4u lo = *(const v4u*)(QK8 + qrow * 2048 + (hh * 2 + mp) * 64 + 32 * h), hi = *(const v4u*)(QK8 + qrow * 2048 + (hh * 2 + mp) * 64 + 32 * h + 16);
            qf = (i32x8){(int)lo.x, (int)lo.y, (int)lo.z, (int)lo.w, (int)hi.x, (int)hi.y, (int)hi.z, (int)hi.w}; }
        const int kkey = 8 * wave + (lane >> 3), kch = (lane & 7) ^ ((kkey >> 1) & 7);
        const char* kbase = (const char*)(QK8 + ((size_t)b * SEQ + kkey) * 2048 + 1024 + hh * 128 + kch * 16);
        const char* vbase = (const char*)(VT8 + (size_t)bh * NT * VT_TILE + wave * 1024 + lane * 16);
        const size_t ctx_shift = ((size_t)TL + (size_t)b * CTXL - ((size_t)b * SEQ + SEQ)) * 2048;
#define AT_DMA(t, slot) do { const size_t off_ = (size_t)(t) * 64 * 2048 + ((t) >= 128 ? ctx_shift : 0); LAS unsigned char* d_ = lds + (slot) * SLOT + wave * 1024; \
        __builtin_amdgcn_global_load_lds((const unsigned*)(kbase + off_), (LAS unsigned*)(d_), 16, 0, 0); \
        __builtin_amdgcn_global_load_lds((const unsigned*)(vbase + (size_t)(t) * VT_TILE), (LAS unsigned*)(d_ + 8192), 16, 0, 0); } while (0)
        AT_DMA(0, 0); AT_DMA(1, 1); AT_DMA(2, 2); AT_DMA(3, 3); AT_DMA(4, 4); AT_DMA(5, 5); AT_DMA(6, 6);
        f32x16 o[4];
#pragma unroll
        for (int d = 0; d < 4; ++d)
#pragma unroll
            for (int i = 0; i < 16; ++i) o[d][i] = 0.f;
        float mref = 0.f, l = 0.f;
        f32x16 negm;
#pragma unroll
        for (int i = 0; i < 16; ++i) negm[i] = 0.f;
        f32x16 sA0, sA1, sB0, sB1;
        i32x8 pwc;
        i32x8 kf0, kf1;
        asm volatile("s_waitcnt vmcnt(10)" ::: "memory"); __builtin_amdgcn_s_barrier();
        AT_LD32(kf0, lds + koff); AT_LD32(kf1, lds + koff + 4096);
        sA0 = __builtin_amdgcn_mfma_scale_f32_32x32x64_f8f6f4(kf0, qf, negm, 0, 0, 0, scale1, 0, scale1);
        sA1 = __builtin_amdgcn_mfma_scale_f32_32x32x64_f8f6f4(kf1, qf, negm, 0, 0, 0, scale1, 0, scale1);
        { asm volatile("s_nop 15\n\ts_nop 7" : "+v"(sA0), "+v"(sA1));     float rm = rowmax32(sA0, sA1);
            { const auto sw_ = __builtin_amdgcn_permlane32_swap(__float_as_uint(rm), __float_as_uint(rm), false, false); rm = fmaxf(__uint_as_float(sw_[0]), __uint_as_float(sw_[1])); } mref = rm;
#pragma unroll
            for (int i = 0; i < 16; ++i) { sA0[i] = __builtin_amdgcn_exp2f(sA0[i] - rm); sA1[i] = __builtin_amdgcn_exp2f(sA1[i] - rm); negm[i] = -rm; l += sA0[i] + sA1[i]; }
#pragma unroll
            for (int q = 0; q < 4; ++q) { pwc[q] = (int)pg8::pk4_fp8(sA0[4 * q], sA0[4 * q + 1], sA0[4 * q + 2], sA0[4 * q + 3]); pwc[4 + q] = (int)pg8::pk4_fp8(sA1[4 * q], sA1[4 * q + 1], sA1[4 * q + 2], sA1[4 * q + 3]); } }
        AT_LD32(kf0, lds + SLOT + koff); AT_LD32(kf1, lds + SLOT + koff + 4096);
        sA0 = __builtin_amdgcn_mfma_scale_f32_32x32x64_f8f6f4(kf0, qf, negm, 0, 0, 0, scale1, 0, scale1);
        sA1 = __builtin_amdgcn_mfma_scale_f32_32x32x64_f8f6f4(kf1, qf, negm, 0, 0, 0, scale1, 0, scale1);
#define AT_PIN16(x) asm volatile("" : "+v"(x))
#define AT_PIN2(a_, b_) asm volatile("" : "+v"(a_), "+v"(b_))
#define AT_GAP(S, base, d) do { AT_PIN16(S); float e_[8]; \
            _Pragma("unroll") for (int k = 0; k < 8; ++k) { e_[k] = __builtin_amdgcn_exp2f(S[(base) + k]); ls += e_[k]; } \
            int w0_ = (int)pg8::pk4_fp8(e_[0], e_[1], e_[2], e_[3]), w1_ = (int)pg8::pk4_fp8(e_[4], e_[5], e_[6], e_[7]); AT_PIN2(w0_, w1_); pwn[2 * (d)] = w0_; pwn[2 * (d) + 1] = w1_; } while (0)
#define AT_PVMFMA(d, V) asm volatile("v_mfma_scale_f32_32x32x64_f8f6f4 %0, %1, %2, %0, %3, %3 op_sel_hi:[0,0,0]" : "+v"(o[d]) : "v"(V), "v"(pwc), "v"(scale1))
#define AT_STEP(C0, C1, N0, N1) do { \
            { const int ahead_ = ((t + 6 < NT - 1) ? t + 6 : NT - 1) - (t + 2); \
              if (ahead_ >= 4) asm volatile("s_waitcnt vmcnt(8)" ::: "memory"); else if (ahead_ == 3) asm volatile("s_waitcnt vmcnt(6)" ::: "memory"); else if (ahead_ == 2) asm volatile("s_waitcnt vmcnt(4)" ::: "memory"); \
              else if (ahead_ == 1) asm volatile("s_waitcnt vmcnt(2)" ::: "memory"); else asm volatile("s_waitcnt vmcnt(0)" ::: "memory"); } \
            __builtin_amdgcn_s_barrier(); \
            if (t + 7 < NT) AT_DMA(t + 7, (t + 7) & 7); \
            const LAS unsigned char* sl = lds + (t & 7) * SLOT; const LAS unsigned char* sn = lds + ((t + 2) & 7) * SLOT; \
            i32x8 va, vb, pwn; float ls = 0.f, fsc = 1.0f; bool resc = false; \
            if (t + 2 < NT) { AT_LD32(kf0, sn + koff); AT_LD32(kf1, sn + koff + 4096); \
                N0 = __builtin_amdgcn_mfma_scale_f32_32x32x64_f8f6f4(kf0, qf, negm, 0, 0, 0, scale1, 0, scale1); \
                N1 = __builtin_amdgcn_mfma_scale_f32_32x32x64_f8f6f4(kf1, qf, negm, 0, 0, 0, scale1, 0, scale1); } \
            AT_LD32(va, sl + voff); AT_LD32(vb, sl + voff + 2048); \
            AT_SB(); \
            { float rm = rowmax32(C0, C1); \
                { const auto sw_ = __builtin_amdgcn_permlane32_swap(__float_as_uint(rm), __float_as_uint(rm), false, false); rm = fmaxf(__uint_as_float(sw_[0]), __uint_as_float(sw_[1])); } \
                if (__any(rm > THR)) { const float dl = fmaxf(rm, 0.f); fsc = __builtin_amdgcn_exp2f(-dl); mref += dl; resc = true; \
                    _Pragma("unroll") for (int i = 0; i < 16; ++i) { C0[i] -= dl; C1[i] -= dl; negm[i] = -mref; } \
                    if (t + 2 < NT) { _Pragma("unroll") for (int i = 0; i < 16; ++i) { N0[i] -= dl; N1[i] -= dl; } } } } \
            AT_SB(); \
            asm volatile("s_nop 1" ::: "memory"); \
            AT_PVMFMA(0, va); AT_LD32(va, sl + voff + 4096); AT_GAP(C0, 0, 0); \
            AT_PVMFMA(1, vb); AT_LD32(vb, sl + voff + 6144); AT_GAP(C0, 8, 1); \
            AT_PVMFMA(2, va); AT_GAP(C1, 0, 2); \
            AT_PVMFMA(3, vb); AT_GAP(C1, 8, 3); \
            if (resc) { asm volatile("s_nop 15\n\ts_nop 15\n\ts_nop 15\n\ts_nop 15\n\ts_nop 15" ::: "memory"); l *= fsc; \
                _Pragma("unroll") for (int d = 0; d < 4; ++d) _Pragma("unroll") for (int i = 0; i < 16; ++i) o[d][i] *= fsc; } \
            l += ls; pwc = pwn; } while (0)
        asm volatile("s_nop 15\n\ts_nop 7" : "+v"(sA0), "+v"(sA1));
        for (int t = 0; t + 1 < NT; t += 2) {
            AT_STEP(sA0, sA1, sB0, sB1);
            ++t; if (t + 1 < NT) AT_STEP(sB0, sB1, sA0, sA1); --t;
        }
#undef AT_STEP
        {
            asm volatile("s_waitcnt vmcnt(0)" ::: "memory"); __builtin_amdgcn_s_barrier();
            const LAS unsigned char* sl = lds + ((NT - 1) & 7) * SLOT; i32x8 vf[4];
#pragma unroll
            for (int d = 0; d < 4; ++d) AT_LD32(vf[d], sl + voff + d * 2048);
            asm volatile("s_nop 1" ::: "memory");
            AT_PVMFMA(0, vf[0]); AT_PVMFMA(1, vf[1]); AT_PVMFMA(2, vf[2]); AT_PVMFMA(3, vf[3]);
        }
#undef AT_PIN16
#undef AT_PIN2
#undef AT_GAP
#undef AT_PVMFMA
#undef AT_DMA
        l += __shfl_xor(l, 32);
        const float inv = 1.0f / l;
        asm volatile("s_nop 15\n\ts_nop 15\n\ts_nop 15\n\ts_nop 15\n\ts_nop 15\n\ts_waitcnt vmcnt(0) lgkmcnt(0)" ::: "memory"); __builtin_amdgcn_s_barrier();
        int l4 = threadIdx.x & 63; asm volatile("" : "+v"(l4));
        LAS float* ex = (LAS float*)lds + (qs * 64) * 64 + l4;
        if (mp == 1) { const float sc1 = inv * tab[TAB_LAM];
#pragma unroll
            for (int d = 0; d < 4; ++d)
#pragma unroll
                for (int i = 0; i < 16; ++i) ex[(d * 16 + i) * 64] = o[d][i] * sc1; }
        asm volatile("s_waitcnt lgkmcnt(0)" ::: "memory"); __builtin_amdgcn_s_barrier();
        if (mp == 0) { float ss = 0.f;
#pragma unroll
            for (int d = 0; d < 4; ++d)
#pragma unroll
                for (int i = 0; i < 16; ++i) { const float v = o[d][i] * inv - ex[(d * 16 + i) * 64]; o[d][i] = v; ss += v * v; }
            ss += __shfl_xor(ss, 32);
            const float rs = rsqrtf(ss * (1.0f / 128.0f) + RMS_EPS) * (1.0f - LAM_INIT);
            int l3 = threadIdx.x & 63; asm volatile("" : "+v"(l3));
            const int h = l3 >> 5;
            unsigned char* orow = (unsigned char*)O + ((size_t)b * SEQ + qb * 128 + qs * 32 + (l3 & 31)) * D + hh * 128 + 16 * h;
#pragma unroll
            for (int d = 0; d < 4; ++d) { unsigned X[4];
#pragma unroll
                for (int g = 0; g < 4; ++g) { const int dv = 32 * d + 8 * g + 4 * h; const f32x4 ng = *(const f32x4*)(norm_g + dv);
                    X[g] = pg8::pk4_fp8(o[d][4 * g] * rs * ng[0], o[d][4 * g + 1] * rs * ng[1], o[d][4 * g + 2] * rs * ng[2], o[d][4 * g + 3] * rs * ng[3]); }
                const auto s02 = __builtin_amdgcn_permlane32_swap(X[0], X[2], false, false); const auto s13 = __builtin_amdgcn_permlane32_swap(X[1], X[3], false, false);
                *(v4u*)(orow + 32 * d) = (v4u){s02[0], s02[1], s13[0], s13[1]}; } }
        asm volatile("s_waitcnt vmcnt(0) lgkmcnt(0)" ::: "memory"); __builtin_amdgcn_s_barrier();
    }
#undef AT_LD32
}
#undef AT_SB
}


namespace gla {
typedef short bf16x8 __attribute__((ext_vector_type(8)));
typedef short s16x4 __attribute__((ext_vector_type(4)));
typedef float f32x16 __attribute__((ext_vector_type(16)));
constexpr int QSTR = 272, KSTR = 144, SEG2_STEP = 98304 - 83968, V2_STEP = 102400 - 53248;
constexpr int QD_OFF = 0, KI_OFF = 17408, KET_OFF = 34816, V_OFF = 53248, AT_OFF = 61440, SBF_OFF = 67584, SEG_OFF = 83968, EBE_OFF = 88064, OT_OFF = 88576;
#define GLA_BAR() do { asm volatile("s_waitcnt lgkmcnt(0)" ::: "memory"); __builtin_amdgcn_s_barrier(); asm volatile("" ::: "memory"); } while (0)
__device__ __forceinline__ s16x4 vtr(const LAS unsigned char* p) { return __builtin_bit_cast(s16x4, __builtin_amdgcn_ds_read_tr16_b64_v4i16((LAS s16x4*)p)); }
__device__ __forceinline__ unsigned cvtpk(float lo, float hi) { unsigned r; asm volatile("v_cvt_pk_bf16_f32 %0, %1, %2" : "=v"(r) : "v"(lo), "v"(hi)); return r; }
__device__ __forceinline__ bf16x8 pack8(const f32x16& x, int s) { v4u w; w.x = cvtpk(x[8 * s], x[8 * s + 1]); w.y = cvtpk(x[8 * s + 2], x[8 * s + 3]); w.z = cvtpk(x[8 * s + 4], x[8 * s + 5]); w.w = cvtpk(x[8 * s + 6], x[8 * s + 7]); return __builtin_bit_cast(bf16x8, w); }
__device__ __forceinline__ void phase(LAS unsigned char* lds, const u16* __restrict__ P, u16* __restrict__ OF, u16* __restrict__ OB, int G, int bx) {
    int tid = threadIdx.x; asm volatile("" : "+v"(tid));
    const int wave = __builtin_amdgcn_readfirstlane(tid >> 6), lane = tid & 63, r = lane & 31, h = lane >> 5, q4 = (lane & 15) >> 2;
    const int trcol = ((lane >> 4) & 1) * 32 + (lane & 3) * 8;
    for (int u = bx; u < 256; u += G) {
        const int vhalf = (u >> 3) & 1, dir = (u >> 4) & 1, hh = u & 7, b = u >> 5;
        u16* O = dir ? OB : OF;
        const int qcol = hh * 128 + 2 * lane, lcol = (3 + dir) * 1024 + hh * 128 + 2 * lane, vcol = 1024 + hh * 128 + vhalf * 64 + 8 * (tid & 7), ocol = hh * 128 + vhalf * 64;
        for (int i = tid; i < 16384 / 16; i += 512) *(LAS v4u*)(lds + SBF_OFF + i * 16) = (v4u){0u, 0u, 0u, 0u};
        f32x16 S0, S1;
#pragma unroll
        for (int i = 0; i < 16; ++i) { S0[i] = 0.f; S1[i] = 0.f; }
        unsigned qraw[2][8], lraw[2][8]; v4u vraw[2];
        const long sg = dir ? -1 : 1;
#define GLA_RB(cc) ((cc) < 4 ? (long)TL + (long)b * CTXL + (dir ? (long)(CTXL - 1) - (long)(cc) * 64 : (long)(cc) * 64) : (long)b * SEQ + (dir ? (long)(SEQ - 1) - (long)((cc) - 4) * 64 : (long)((cc) - 4) * 64))
#define GLA_LOAD(cc, st) do { const long rb_ = GLA_RB(cc); const u16* pw_ = P + (rb_ + sg * (8 * wave)) * HGN; const long rs_ = sg * HGN; \
        _Pragma("unroll") for (int i = 0; i < 8; ++i) { qraw[st][i] = *(const unsigned*)(pw_ + rs_ * i + qcol); lraw[st][i] = *(const unsigned*)(pw_ + rs_ * i + lcol); } \
        vraw[st] = __builtin_nontemporal_load((const v4u*)(P + (rb_ + sg * (long)(tid >> 3)) * HGN + vcol)); } while (0)
#define GLA_PRE(st) do { float c0_ = 0.f, c1_ = 0.f; _Pragma("unroll") for (int i = 0; i < 8; ++i) { c0_ += h2f(lraw[st][i] & 0xffffu); c1_ += h2f(lraw[st][i] >> 16); } \
            *(LAS f32x2*)(lds + SEG_OFF + (st) * SEG2_STEP + (wave * 128 + 2 * lane) * 4) = (f32x2){c0_, c1_}; \
            { const int t = tid >> 3, vc = tid & 7; *(LAS v4u*)(lds + V_OFF + (st) * V2_STEP + ((vc >> 2) * 4 + (t >> 4)) * 1024 + (t & 15) * 64 + (vc & 3) * 16) = vraw[st]; } } while (0)
        GLA_LOAD(0, 0); GLA_LOAD(1, 1);
        GLA_PRE(0); GLA_BAR();
        auto chunk = [&](const int cc, auto SETC) __attribute__((always_inline)) {
            constexpr int st = decltype(SETC)::value;
            float lf0[8], lf1[8];
#pragma unroll
            for (int i = 0; i < 8; ++i) { lf0[i] = h2f(lraw[st][i] & 0xffffu); lf1[i] = h2f(lraw[st][i] >> 16); }
            float off0 = 0.f, off1 = 0.f, tot0 = 0.f, tot1 = 0.f;
#pragma unroll
            for (int s = 0; s < 8; ++s) { const f32x2 v = *(const LAS f32x2*)(lds + SEG_OFF + st * SEG2_STEP + (s * 128 + 2 * lane) * 4); if (s < wave) { off0 += v.x; off1 += v.y; } tot0 += v.x; tot1 += v.y; }
            const float eb0 = __builtin_amdgcn_exp2f(tot0), eb1 = __builtin_amdgcn_exp2f(tot1);
            if (wave == 0) *(LAS f32x2*)(lds + EBE_OFF + 2 * lane * 4) = (f32x2){eb0, eb1};
            unsigned ke0[4], ke1[4];
            float e0 = __builtin_amdgcn_exp2f(off0), e1 = __builtin_amdgcn_exp2f(off1);
#pragma unroll
            for (int i = 0; i < 8; i += 2) { float x0[2], x1[2];
#pragma unroll
                for (int u = 0; u < 2; ++u) { const int ii = i + u;
                    const float f0 = __builtin_amdgcn_exp2f(lf0[ii]), f1 = __builtin_amdgcn_exp2f(lf1[ii]), k0 = 1.0f - f0, k1 = 1.0f - f1;
                    e0 *= f0; e1 *= f1;
                    const float ei0 = __builtin_amdgcn_rcpf(e0), ei1 = __builtin_amdgcn_rcpf(e1);
                    const float q0 = bflo(qraw[st][ii]), q1 = bfhi(qraw[st][ii]);
                    const int t = 8 * wave + ii;
                    *(LAS unsigned*)(lds + QD_OFF + t * QSTR + lane * 4) = cvtpk(q0 * e0, q1 * e1);
                    *(LAS unsigned*)(lds + KI_OFF + t * QSTR + lane * 4) = cvtpk(k0 * ei0, k1 * ei1);
                    x0[u] = k0 * ei0 * eb0; x1[u] = k1 * ei1 * eb1; }
                ke0[i >> 1] = cvtpk(x0[0], x0[1]); ke1[i >> 1] = cvtpk(x1[0], x1[1]); }
            *(LAS v4u*)(lds + KET_OFF + (2 * lane) * KSTR + wave * 16) = (v4u){ke0[0], ke0[1], ke0[2], ke0[3]};
            *(LAS v4u*)(lds + KET_OFF + (2 * lane + 1) * KSTR + wave * 16) = (v4u){ke1[0], ke1[1], ke1[2], ke1[3]};
            if (cc + 2 < 132) GLA_LOAD(cc + 2, st);
            GLA_BAR();
            f32x16 acc;
#pragma unroll
            for (int i = 0; i < 16; ++i) acc[i] = 0.f;
            if (wave < 3) { const int sb = wave >> 1, tb = (wave + 1) >> 1;
#pragma unroll
                for (int ks = 0; ks < 8; ++ks) { const bf16x8 a = *(const LAS bf16x8*)(lds + KI_OFF + (32 * sb + r) * QSTR + (16 * ks + 8 * h) * 2), bq = *(const LAS bf16x8*)(lds + QD_OFF + (32 * tb + r) * QSTR + (16 * ks + 8 * h) * 2);
                    acc = __builtin_amdgcn_mfma_f32_32x32x16_bf16(a, bq, acc, 0, 0, 0); }
                if (sb == tb) {
#pragma unroll
                    for (int i = 0; i < 16; ++i) { const int srow = (i & 3) + 8 * (i >> 2) + 4 * h; if (srow > r) acc[i] = 0.f; } }
                *(LAS bf16x8*)(lds + AT_OFF + (wave * 2 + 0) * 1024 + lane * 16) = pack8(acc, 0);
                *(LAS bf16x8*)(lds + AT_OFF + (wave * 2 + 1) * 1024 + lane * 16) = pack8(acc, 1);
            } else if (wave >= 4) { const int tb = (wave - 4) >> 1, vb = (wave - 4) & 1;
#pragma unroll
                for (int ks = 0; ks < 8; ++ks) { const LAS unsigned char* qp = lds + QD_OFF + (32 * tb + r) * QSTR + (16 * ks + 4 * h) * 2;
                    const v2u lo = *(const LAS v2u*)qp, hi = *(const LAS v2u*)(qp + 16);
                    const bf16x8 a = __builtin_bit_cast(bf16x8, (v4u){lo.x, lo.y, hi.x, hi.y});
                    const bf16x8 bs = *(const LAS bf16x8*)(lds + SBF_OFF + (((ks >> 1) * 2 + vb) * 2 + (ks & 1)) * 1024 + lane * 16);
                    acc = __builtin_amdgcn_mfma_f32_32x32x16_bf16(a, bs, acc, 0, 0, 0); } }
            GLA_BAR();
            if (wave >= 4) { const int tb = (wave - 4) >> 1, vb = (wave - 4) & 1;
#pragma unroll
                for (int sb = 0; sb < 2; ++sb) { if (sb <= tb) {
#pragma unroll
                    for (int sub = 0; sub < 2; ++sub) { const bf16x8 a = *(const LAS bf16x8*)(lds + AT_OFF + ((sb + tb) * 2 + sub) * 1024 + lane * 16);
                        const LAS unsigned char* vp = lds + V_OFF + st * V2_STEP + (vb * 4 + 2 * sb + sub) * 1024 + (4 * h + q4) * 64 + trcol; const s16x4 lo = vtr(vp), hi = vtr(vp + 512);
                        const bf16x8 bv = {lo[0], lo[1], lo[2], lo[3], hi[0], hi[1], hi[2], hi[3]};
                        acc = __builtin_amdgcn_mfma_f32_32x32x16_bf16(a, bv, acc, 0, 0, 0); } } }
                u16* ob_ = O + (GLA_RB(cc) + sg * (long)(32 * tb + 4 * h)) * D + ocol + 32 * vb + r; const long os_ = sg * D;
#pragma unroll
                for (int i = 0; i < 16; ++i) ob_[os_ * ((i & 3) + 8 * (i >> 2))] = (u16)f2bf(acc[i]);
            } else { const int kb = wave;
#pragma unroll
                for (int g = 0; g < 4; ++g) { const f32x4 e = *(const LAS f32x4*)(lds + EBE_OFF + (32 * kb + 8 * g + 4 * h) * 4);
#pragma unroll
                    for (int i = 0; i < 4; ++i) { S0[4 * g + i] *= e[i]; S1[4 * g + i] *= e[i]; } }
#pragma unroll
                for (int s4 = 0; s4 < 4; ++s4) { const bf16x8 a = *(const LAS bf16x8*)(lds + KET_OFF + (32 * kb + r) * KSTR + (16 * s4 + 8 * h) * 2);
                    const LAS unsigned char* vp0 = lds + V_OFF + st * V2_STEP + (0 * 4 + s4) * 1024 + (8 * h + q4) * 64 + trcol; const s16x4 l0 = vtr(vp0), h0 = vtr(vp0 + 256);
                    const LAS unsigned char* vp1 = lds + V_OFF + st * V2_STEP + (1 * 4 + s4) * 1024 + (8 * h + q4) * 64 + trcol; const s16x4 l1 = vtr(vp1), h1 = vtr(vp1 + 256);
                    const bf16x8 bv0 = {l0[0], l0[1], l0[2], l0[3], h0[0], h0[1], h0[2], h0[3]}, bv1 = {l1[0], l1[1], l1[2], l1[3], h1[0], h1[1], h1[2], h1[3]};
                    S0 = __builtin_amdgcn_mfma_f32_32x32x16_bf16(a, bv0, S0, 0, 0, 0); S1 = __builtin_amdgcn_mfma_f32_32x32x16_bf16(a, bv1, S1, 0, 0, 0); }
                *(LAS bf16x8*)(lds + SBF_OFF + ((kb * 2 + 0) * 2 + 0) * 1024 + lane * 16) = pack8(S0, 0);
                *(LAS bf16x8*)(lds + SBF_OFF + ((kb * 2 + 0) * 2 + 1) * 1024 + lane * 16) = pack8(S0, 1);
                *(LAS bf16x8*)(lds + SBF_OFF + ((kb * 2 + 1) * 2 + 0) * 1024 + lane * 16) = pack8(S1, 0);
                *(LAS bf16x8*)(lds + SBF_OFF + ((kb * 2 + 1) * 2 + 1) * 1024 + lane * 16) = pack8(S1, 1);
            }
            if (cc + 1 < 132) GLA_PRE(st ^ 1);
            GLA_BAR();
        };
        for (int cc = 0; cc < 132; cc += 2) { chunk(cc, std::integral_constant<int, 0>{}); chunk(cc + 1, std::integral_constant<int, 1>{}); }
#undef GLA_RB
#undef GLA_LOAD
#undef GLA_PRE
        asm volatile("s_waitcnt vmcnt(0)" ::: "memory");
    }
}
#undef GLA_BAR
}

struct Args {
    const float* in[22];
    float* out; unsigned char* ws;
    int s_lo, s_hi;
};
enum { I_X = 0, I_C, I_CTX, I_CCTX, I_WADA, I_BADA, I_LNG, I_LNB, I_HGWIN, I_HGLB, I_HGNG, I_HGWOUT, I_DAWIN, I_DALAM, I_DANG, I_DAWOUT, I_WR, I_BR, I_WGU, I_BGU, I_WDN, I_BDN };

__device__ __forceinline__ void p0_transpose_item(const float* W, int K, int N, u16* WT, int k0, int n0, int row0, LAS float* scr, int lane) {
#pragma unroll 8
    for (int i = 0; i < 32; ++i) { const int kk = 2 * i + (lane >> 5); scr[kk * 33 + (lane & 31)] = W[(size_t)(k0 + kk) * N + n0 + (lane & 31)]; }
    asm volatile("s_waitcnt lgkmcnt(0)" ::: "memory");
    const int c = lane & 7;
#pragma unroll
    for (int j = 0; j < 4; ++j) { const int n = (lane >> 3) + 8 * j; const LAS float* s = scr + (8 * c) * 33 + n;
        v4u o; o.x = pk2(s[0 * 33], s[1 * 33]); o.y = pk2(s[2 * 33], s[3 * 33]); o.z = pk2(s[4 * 33], s[5 * 33]); o.w = pk2(s[6 * 33], s[7 * 33]);
        *(GAS v4u*)(WT + (size_t)(row0 + n) * K + k0 + 8 * c) = o; }
    asm volatile("s_waitcnt lgkmcnt(0)" ::: "memory");
}


__device__ __forceinline__ void p0_transpose_item_f8(const float* W, int K, int N, unsigned char* WT, int k0, int n0, int row0, float scale, LAS float* scr, int lane) {
#pragma unroll 8
    for (int i = 0; i < 32; ++i) { const int kk = 2 * i + (lane >> 5); scr[kk * 33 + (lane & 31)] = __builtin_nontemporal_load(W + (size_t)(k0 + kk) * N + n0 + (lane & 31)) * scale; }
    asm volatile("s_waitcnt lgkmcnt(0)" ::: "memory");
    const int c = lane & 3;
#pragma unroll
    for (int j = 0; j < 2; ++j) { const int n = (lane >> 2) + 16 * j; const LAS float* sp = scr + (16 * c) * 33 + n;
        v4u o; o.x = pg8::pk4_fp8(sp[0 * 33], sp[1 * 33], sp[2 * 33], sp[3 * 33]); o.y = pg8::pk4_fp8(sp[4 * 33], sp[5 * 33], sp[6 * 33], sp[7 * 33]);
        o.z = pg8::pk4_fp8(sp[8 * 33], sp[9 * 33], sp[10 * 33], sp[11 * 33]); o.w = pg8::pk4_fp8(sp[12 * 33], sp[13 * 33], sp[14 * 33], sp[15 * 33]);
        __builtin_nontemporal_store(o, (GAS v4u*)(WT + (size_t)(row0 + n) * K + k0 + 16 * c)); }
    asm volatile("s_waitcnt lgkmcnt(0)" ::: "memory");
}


__global__ void __launch_bounds__(NWAVES * 64, 2) fwd(Args args) {
    extern __shared__ __attribute__((aligned(16))) unsigned char lds_raw[];
    LAS unsigned char* lds = (LAS unsigned char*)lds_raw;
    volatile LAS unsigned* MISC = (volatile LAS unsigned*)(lds + MISC_OFF);
    LAS int* l_tp = (LAS int*)(lds + MISC_OFF + 32);
    LAS int* l_cnt = (LAS int*)(lds + MISC_OFF + 192);
    const int tid = threadIdx.x, lane = tid & 63, wave = __builtin_amdgcn_readfirstlane(tid >> 6);
    const int G = gridDim.x, bx = blockIdx.x;
    const int gw = bx * NWAVES + wave, NGW = G * NWAVES;
    unsigned char* ws = args.ws;
    unsigned* ctl = (unsigned*)(ws + WS_CTL);
    float* MOD = (float*)(ws + WS_MOD);
    float* TAB = (float*)(ws + WS_TAB);
    v2u* TI = (v2u*)(ws + WS_TI);
    int* LIST = (int*)(ws + WS_LIST);
    u16* WHGIN = (u16*)(ws + WS_WHGIN); u16* WHGOUT = (u16*)(ws + WS_WHGOUT); u16* WDAIN = (u16*)(ws + WS_WDAIN); u16* WDAOUT = (u16*)(ws + WS_WDAOUT);
    u16* WGU = (u16*)(ws + WS_WGU); u16* WDN = (u16*)(ws + WS_WDN);
    u16* PROJ0 = (u16*)(ws + WS_PROJ0); u16* ACT = (u16*)(ws + WS_ACT); unsigned char* QK8 = ws + WS_QK8; u16* VB = (u16*)(ws + WS_VB); unsigned char* VT8 = ws + WS_VT8; u16* OATT = (u16*)(ws + WS_O);
    u16* OF = (u16*)(ws + WS_OF); u16* OB = (u16*)(ws + WS_OB); u16* ARO = (u16*)(ws + WS_ARO); u16* ML = (u16*)(ws + WS_ML); u16* Y = (u16*)(ws + WS_Y);
    u16* XL = (u16*)(ws + WS_XL);
    u16* H = (u16*)args.out;
    const float* x = args.in[I_X]; const float* ctxin = args.in[I_CTX];

    if (tid < 128) ((LAS unsigned*)(lds + MISC_OFF))[tid] = 0u;
    __syncthreads();
    XcdBarrier bar = xcd_barrier_post(ctl + CW_BAR, MISC);
    const int lo = args.s_lo, hi = args.s_hi;
#define IN(k) (lo <= (k) && (k) < hi)
#define FRESH_IDS int tid_ = threadIdx.x; asm volatile("" : "+v"(tid_)); const int tid = tid_, lane = tid_ & 63; (void)tid; (void)lane;
#define SEAM(k) do { if (IN(k) && IN((k) + 1)) xcd_barrier(bar); } while (0)

    if (IN(0)) { FRESH_IDS
        LAS float* silu_t = (LAS float*)(lds + 73728);
        for (int i = tid; i < 9 * 1024; i += NWAVES * 64) { const int r = i >> 10, k = i & 1023; const float v = r < 8 ? args.in[I_C][r * 1024 + k] : args.in[I_CCTX][k]; silu_t[i] = v * sigmoidf_(v); }
        __syncthreads();
        { LAS float* red = (LAS float*)(lds + 110592);
          for (int it = bx; it < 2 * 96; it += G) {
            const int l = it / 96, n = (it % 96) * 64 + lane;
            const float* W = args.in[I_WADA] + (size_t)l * 1024 * 6144 + n;
            float a[9];
#pragma unroll
            for (int r = 0; r < 9; ++r) a[r] = 0.f;
#pragma unroll 8
            for (int k = wave * 128; k < wave * 128 + 128; ++k) { const float w = __builtin_nontemporal_load(W + (size_t)k * 6144);
#pragma unroll
                for (int r = 0; r < 9; ++r) a[r] += silu_t[r * 1024 + k] * w; }
#pragma unroll
            for (int r = 0; r < 9; ++r) red[(wave * 9 + r) * 64 + lane] = a[r];
            __syncthreads();
            for (int o = tid; o < 9 * 64; o += NWAVES * 64) { const int r = o >> 6, ln = o & 63; float sum = args.in[I_BADA][l * 6144 + (it % 96) * 64 + ln];
#pragma unroll
                for (int w = 0; w < 8; ++w) sum += red[(w * 9 + r) * 64 + ln];
                MOD[((size_t)l * 9 + r) * 6144 + (it % 96) * 64 + ln] = sum; }
            __syncthreads();
          } }
        LAS float* scr = (LAS float*)(lds + wave * 9216);
        constexpr int I_A = 16 * 160, I_B = 16 * 32, I_Cc = 16 * 96, I_D = 16 * 32, I_E = 64 * 16 * 64, I_F = 64 * 16 * 32;
        constexpr int NITEMS = I_A + I_B + I_Cc + I_D + I_E + I_F;
        for (int it = gw; it < NITEMS; it += NGW) {
            int r = it;
            if (r < I_A) { const int kb = r / 160, nb = r % 160; p0_transpose_item_f8(args.in[I_HGWIN], 1024, 5120, (unsigned char*)WHGIN, kb * 64, nb * 32, nb * 32, 32.0f, scr, lane); continue; } r -= I_A;
            if (r < I_B) { const int kb = r / 32, nb = r % 32; p0_transpose_item_f8(args.in[I_HGWOUT], 1024, 1024, (unsigned char*)WHGOUT, kb * 64, nb * 32, nb * 32, 64.0f, scr, lane); continue; } r -= I_B;
            if (r < I_Cc) { const int kb = r / 96, nb = r % 96; p0_transpose_item_f8(args.in[I_DAWIN], 1024, 3072, (unsigned char*)WDAIN, kb * 64, nb * 32, nb * 32, 32.0f, scr, lane); continue; } r -= I_Cc;
            if (r < I_D) { const int kb = r / 32, nb = r % 32; p0_transpose_item_f8(args.in[I_DAWOUT], 1024, 1024, (unsigned char*)WDAOUT, kb * 64, nb * 32, nb * 32, 64.0f, scr, lane); continue; } r -= I_D;
            if (r < I_E) { const int le = r / 1024, q = r % 1024, kb = q / 64, nb = q % 64; const int n0 = nb * 32;
                const int j = n0 & 1023, row0 = (j >> 7) * 256 + (n0 >= 1024 ? 128 : 0) + (j & 127);
                p0_transpose_item_f8(args.in[I_WGU] + (size_t)le * 1024 * 2048, 1024, 2048, (unsigned char*)WGU + (size_t)le * 2048 * 1024, kb * 64, n0, row0, 32.0f, scr, lane); continue; } r -= I_E;
            { const int le = r / 512, q = r % 512, kb = q / 32, nb = q % 32;
                p0_transpose_item_f8(args.in[I_WDN] + (size_t)le * 1024 * 1024, 1024, 1024, (unsigned char*)WDN + (size_t)le * 1024 * 1024, kb * 64, nb * 32, nb * 32, 64.0f, scr, lane); }
        }
        if (bx == 0) {
            for (int i = tid; i < 2048; i += NWAVES * 64) { const int pos = i >> 4, j = i & 15; const float inv = powf(10000.0f, -(float)j / 16.0f); const float ang = (float)pos * inv; TAB[TAB_COS + i] = cosf(ang); TAB[TAB_SIN + i] = sinf(ang); }
            for (int i = tid; i < 2048; i += NWAVES * 64) { const int d = i >> 10, j = i & 1023; const float* t = args.in[I_HGLB] + (size_t)d * 3 * 1024 + j;
                const float t0 = t[0], t1 = t[1024], t2 = t[2048], m = fmaxf(t0, fmaxf(t1, t2)); const float e0 = expf(t0 - m), e1 = expf(t1 - m), e2 = expf(t2 - m); TAB[TAB_LB + i] = e0 / (e0 + e1 + e2); }
            if (tid == 0) { const float* lp = args.in[I_DALAM]; float s01 = 0.f, s23 = 0.f; for (int j = 0; j < 64; ++j) { s01 += lp[j] * lp[64 + j]; s23 += lp[128 + j] * lp[192 + j]; }
                TAB[TAB_LAM] = expf(s01) - expf(s23) + LAM_INIT; }
        }
    }
    SEAM(0);
    if (IN(1)) { FRESH_IDS
        for (int r0 = gw; r0 < TT; r0 += 4 * NGW) {
            f32x4 v[4][4];
#pragma unroll
            for (int q = 0; q < 4; ++q) { const int r = r0 + q * NGW; if (r < TT) { const float* xr = r < TL ? x + (size_t)r * D : ctxin + (size_t)(r - TL) * D;
#pragma unroll
                for (int j = 0; j < 4; ++j) v[q][j] = __builtin_nontemporal_load((const f32x4*)(xr + 4 * lane + 256 * j)); } }
#pragma unroll
            for (int q = 0; q < 4; ++q) { const int r = r0 + q * NGW; if (r < TT) { const int bb = r < TL ? (r >> 13) : 8; const float* md = MOD + (size_t)bb * 6144;
#pragma unroll
                for (int j = 0; j < 4; ++j) { const int c = 4 * lane + 256 * j; const f32x4 sh = *(const f32x4*)(md + c), sc = *(const f32x4*)(md + 1024 + c);
                    const f32x4 hv = v[q][j] * (sc + 1.0f) + sh; *(unsigned*)((unsigned char*)H + (size_t)r * D + c) = pg8::pk4_fp8(hv[0], hv[1], hv[2], hv[3]); } } }
        }
    }
    SEAM(1);
    if (IN(2)) {
        pg8::StaticOrder S; S.init(TT, HGN, G, bx); pg8::DenseAB8 am{(const unsigned char*)H, (const unsigned char*)WHGIN}; pg8::EpiHgProj E{PROJ0, TAB + TAB_LB, 1.0f / 32.0f};
        pg8::gemm_phase_f8<pg8::EpiHgProj, pg8::StaticOrder, pg8::DenseAB8>(lds, S, E, am);
    }
    SEAM(2);
    if (IN(3)) gla::phase(lds, PROJ0, OF, OB, G, bx);
    SEAM(3);
    if (IN(4)) { FRESH_IDS
        const float* ng = args.in[I_HGNG];
        const int rpw = TT / NGW, rbeg = gw * rpw, rend = rbeg + rpw;
        f32x4 n4v[4]; v2u an[4], bn[4], gn[4];
#pragma unroll
        for (int j = 0; j < 4; ++j) n4v[j] = *(const f32x4*)(ng + 4 * lane + 256 * j);
#define S4_ISSUE(rr) do { const size_t r_ = (size_t)(rr); _Pragma("unroll") for (int j = 0; j < 4; ++j) { const int c = 4 * lane + 256 * j; \
            an[j] = __builtin_nontemporal_load((const v2u*)(OF + r_ * D + c)); bn[j] = __builtin_nontemporal_load((const v2u*)(OB + r_ * D + c)); gn[j] = __builtin_nontemporal_load((const v2u*)(PROJ0 + r_ * HGN + 2048 + c)); } } while (0)
        S4_ISSUE(rbeg);
        for (int r = rbeg; r < rend; ++r) {
            v2u ac[4], bc[4], gc[4];
#pragma unroll
            for (int j = 0; j < 4; ++j) { ac[j] = an[j]; bc[j] = bn[j]; gc[j] = gn[j]; }
            if (r + 1 < rend) S4_ISSUE(r + 1);
            f32x4 o[4]; float ss[4];
#pragma unroll
            for (int j = 0; j < 4; ++j) { const v2u a = ac[j], b2 = bc[j];
                o[j] = (f32x4){bflo(a.x) + bflo(b2.x), bfhi(a.x) + bfhi(b2.x), bflo(a.y) + bflo(b2.y), bfhi(a.y) + bfhi(b2.y)};
                ss[j] = o[j][0] * o[j][0] + o[j][1] * o[j][1] + o[j][2] * o[j][2] + o[j][3] * o[j][3]; }
#pragma unroll
            for (int sft = 1; sft < 16; sft <<= 1) {
#pragma unroll
                for (int j = 0; j < 4; ++j) ss[j] += __shfl_xor(ss[j], sft); }
#pragma unroll
            for (int j = 0; j < 4; ++j) { const auto s16 = __builtin_amdgcn_permlane16_swap(__float_as_uint(ss[j]), __float_as_uint(ss[j]), false, false); ss[j] = __uint_as_float(s16[0]) + __uint_as_float(s16[1]); }
#pragma unroll
            for (int j = 0; j < 4; ++j) { const int c = 4 * lane + 256 * j;
                const float rs = rsqrtf(ss[j] * (1.0f / 128.0f) + RMS_EPS);
                const v2u gg = gc[j]; const f32x4 g4 = {bflo(gg.x), bfhi(gg.x), bflo(gg.y), bfhi(gg.y)};
                f32x4 res;
#pragma unroll
                for (int i = 0; i < 4; ++i) res[i] = o[j][i] * rs * n4v[j][i] * (g4[i] * sigmoidf_(g4[i]));
                *(unsigned*)((unsigned char*)ARO + (size_t)r * D + c) = pg8::pk4_fp8(res[0], res[1], res[2], res[3]); }
        }
#undef S4_ISSUE
    }
    SEAM(4);
    auto layer_body = [&](auto LC) __attribute__((always_inline)) {
        constexpr int l = decltype(LC)::value;
        const int sb = l ? 12 : 5;
        const int nrows = l ? TL : TT;
        if (l == 1) {
            if (IN(10)) {
                pg8::StaticOrder S; S.init(TT, DAN, G, bx); pg8::DenseAB8 am{(const unsigned char*)H, (const unsigned char*)WDAIN}; pg8::EpiDaProj E{QK8, VB, TAB, 1.0f / 32.0f};
                pg8::gemm_phase_f8<pg8::EpiDaProj, pg8::StaticOrder, pg8::DenseAB8>(lds, S, E, am);
            }
            SEAM(10);
            if (IN(11)) { attn::vtile(VB, VT8, G, bx); xcd_barrier(bar);
                attn::phase(lds, QK8, VT8, OATT, TAB, args.in[I_DANG], G, bx); }
            SEAM(11);
        }
        if (IN(sb)) {
            pg8::StaticOrder S; S.init(nrows, D, G, bx); pg8::DenseAB8 am{(const unsigned char*)(l ? OATT : ARO), (const unsigned char*)(l ? WDAOUT : WHGOUT)}; pg8::EpiBf16 E{ML, D, nullptr, 0, 1.0f / 64.0f};
            pg8::gemm_phase_f8<pg8::EpiBf16, pg8::StaticOrder, pg8::DenseAB8>(lds, S, E, am);
        }
        SEAM(sb);
        if (IN(sb + 1)) { FRESH_IDS
            const float* lng = args.in[I_LNG] + (size_t)(l * 2 + 0) * D; const float* lnb = args.in[I_LNB] + (size_t)(l * 2 + 0) * D;
            const float* wr_ = args.in[I_WR] + (size_t)l * D * NE; const float* br_ = args.in[I_BR] + l * NE;
            unsigned* cnt = ctl + CW_CNT + l * 32;
            constexpr int HSTR = 2064, HLO_OFF = 16 * HSTR, PART_OFF = 2 * HLO_OFF;
            LAS unsigned* lcount = (LAS unsigned*)(lds + MISC_OFF + 384);
            LAS unsigned* lbase = lcount + 32;
            LAS unsigned* lslot = (LAS unsigned*)(lds + MISC_OFF + 1024);
            LAS float* part = (LAS float*)(lds + PART_OFF);
            unsigned* TIu = (unsigned*)TI;
            if (tid < 32) lcount[tid] = 0u;
            const int fr = lane & 15, kq = lane >> 4;
            pg8::bf16x8 bh[4][2], bl[4][2];
#pragma unroll
            for (int ks = 0; ks < 4; ++ks)
#pragma unroll
                for (int eb = 0; eb < 2; ++eb) { unsigned hw[4], lw[4];
#pragma unroll
                    for (int i2 = 0; i2 < 4; ++i2) { const int c = 128 * wave + 32 * ks + 8 * kq + 2 * i2; const float w0 = wr_[(size_t)c * NE + 16 * eb + fr], w1 = wr_[(size_t)(c + 1) * NE + 16 * eb + fr];
                        const unsigned hp = pg8::cvt_pk_bf16(w0, w1); hw[i2] = hp; lw[i2] = pg8::cvt_pk_bf16(w0 - bflo(hp), w1 - bfhi(hp)); }
                    bh[ks][eb] = __builtin_bit_cast(pg8::bf16x8, (v4u){hw[0], hw[1], hw[2], hw[3]}); bl[ks][eb] = __builtin_bit_cast(pg8::bf16x8, (v4u){lw[0], lw[1], lw[2], lw[3]}); }
            __syncthreads();
            const int rpb = nrows / G, rbase = bx * rpb, ngr = (rpb + 15) >> 4;
            f32x4 lngv[4], lnbv[4], g1v[4], shv[4], scv[4]; int cur_bb = -1;
#pragma unroll
            for (int j = 0; j < 4; ++j) { const int c = 4 * lane + 256 * j; lngv[j] = *(const f32x4*)(lng + c); lnbv[j] = *(const f32x4*)(lnb + c); }
            f32x4 xn[4]; v2u mn[4];
#define RT_ISSUE(rr) do { const int r_ = (rr); _Pragma("unroll") for (int j = 0; j < 4; ++j) { const int c = 4 * lane + 256 * j; \
                    if (l == 0) { const float* xr_ = (r_ < TL ? x + (size_t)r_ * D : ctxin + (size_t)(r_ - TL) * D); xn[j] = __builtin_nontemporal_load((const f32x4*)(xr_ + c)); } \
                    else { const v2u xx_ = __builtin_nontemporal_load((const v2u*)(XL + (size_t)r_ * D + c)); xn[j] = (f32x4){__uint_as_float(xx_.x), __uint_as_float(xx_.y), 0.f, 0.f}; } \
                    mn[j] = __builtin_nontemporal_load((const v2u*)(ML + (size_t)r_ * D + c)); } } while (0)
            if (2 * wave < rpb) RT_ISSUE(rbase + 2 * wave);
            for (int g = 0; g < ngr; ++g) {
#pragma unroll
                for (int q = 0; q < 2; ++q) { const int lr = 16 * g + 2 * wave + q;
                    if (lr < rpb) { const int r = rbase + lr;
                        const int bb = r < TL ? (r >> 13) : 8;
                        if (bb != cur_bb) { cur_bb = bb; const float* md = MOD + ((size_t)l * 9 + bb) * 6144;
#pragma unroll
                            for (int j = 0; j < 4; ++j) { const int c = 4 * lane + 256 * j; g1v[j] = *(const f32x4*)(md + 2048 + c); shv[j] = *(const f32x4*)(md + 3072 + c); scv[j] = *(const f32x4*)(md + 4096 + c); } }
                        f32x4 v[4]; float s = 0.f;
#pragma unroll
                        for (int j = 0; j < 4; ++j) { f32x4 xv; if (l == 0) xv = xn[j]; else { const unsigned x0 = __float_as_uint(xn[j][0]), x1 = __float_as_uint(xn[j][1]); xv = (f32x4){bflo(x0), bfhi(x0), bflo(x1), bfhi(x1)}; }
                            const v2u mm = mn[j];
                            const f32x4 m4 = {bflo(mm.x), bfhi(mm.x), bflo(mm.y), bfhi(mm.y)}; v[j] = xv * DN_ALPHA + g1v[j] * m4; s += (v[j][0] + v[j][1]) + (v[j][2] + v[j][3]); }
                        { const int ln = q == 0 ? lr + 1 : lr + 15; if (ln < rpb) RT_ISSUE(rbase + ln); }
                        const float mean = wave_sum(s) * (1.0f / D); float s2 = 0.f;
#pragma unroll
                        for (int j = 0; j < 4; ++j) { v[j] = v[j] - mean; s2 += (v[j][0] * v[j][0] + v[j][1] * v[j][1]) + (v[j][2] * v[j][2] + v[j][3] * v[j][3]); }
                        const float rstd = rsqrtf(wave_sum(s2) * (1.0f / D) + LN_EPS);
#pragma unroll
                        for (int j = 0; j < 4; ++j) { const int c = 4 * lane + 256 * j;
                            const f32x4 y = v[j] * rstd * lngv[j] + lnbv[j]; { v2u xo; xo.x = pk2(y[0], y[1]); xo.y = pk2(y[2], y[3]); __builtin_nontemporal_store(xo, (v2u*)(XL + (size_t)r * D + c)); }
                            const f32x4 hv = y * (scv[j] + 1.0f) + shv[j]; *(unsigned*)((unsigned char*)H + (size_t)r * D + c) = pg8::pk4_fp8(hv[0], hv[1], hv[2], hv[3]);
                            const unsigned h0 = pg8::cvt_pk_bf16(hv[0], hv[1]), h1 = pg8::cvt_pk_bf16(hv[2], hv[3]);
                            const unsigned l0 = pg8::cvt_pk_bf16(hv[0] - bflo(h0), hv[1] - bfhi(h0)), l1 = pg8::cvt_pk_bf16(hv[2] - bflo(h1), hv[3] - bfhi(h1));
                            *(LAS v2u*)(lds + (2 * wave + q) * HSTR + c * 2) = (v2u){h0, h1}; *(LAS v2u*)(lds + HLO_OFF + (2 * wave + q) * HSTR + c * 2) = (v2u){l0, l1}; } } }
                __syncthreads();
                {
                    pg8::f32x4 acc0 = {0.f, 0.f, 0.f, 0.f}, acc1 = {0.f, 0.f, 0.f, 0.f};
#pragma unroll
                    for (int ks = 0; ks < 4; ++ks) { const LAS unsigned char* ap = lds + fr * HSTR + (128 * wave + 32 * ks + 8 * kq) * 2;
                        const pg8::bf16x8 ah = *(const LAS pg8::bf16x8*)ap, al = *(const LAS pg8::bf16x8*)(ap + HLO_OFF);
                        acc0 = __builtin_amdgcn_mfma_f32_16x16x32_bf16(ah, bh[ks][0], acc0, 0, 0, 0); acc1 = __builtin_amdgcn_mfma_f32_16x16x32_bf16(ah, bh[ks][1], acc1, 0, 0, 0);
                        acc0 = __builtin_amdgcn_mfma_f32_16x16x32_bf16(al, bh[ks][0], acc0, 0, 0, 0); acc1 = __builtin_amdgcn_mfma_f32_16x16x32_bf16(al, bh[ks][1], acc1, 0, 0, 0);
                        acc0 = __builtin_amdgcn_mfma_f32_16x16x32_bf16(ah, bl[ks][0], acc0, 0, 0, 0); acc1 = __builtin_amdgcn_mfma_f32_16x16x32_bf16(ah, bl[ks][1], acc1, 0, 0, 0); }
#pragma unroll
                    for (int i2 = 0; i2 < 4; ++i2) { part[(wave * 16 + 4 * kq + i2) * 32 + fr] = acc0[i2]; part[(wave * 16 + 4 * kq + i2) * 32 + 16 + fr] = acc1[i2]; } }
                __syncthreads();
#pragma unroll
                for (int q = 0; q < 2; ++q) { const int lr = 16 * g + 2 * wave + q;
                    if (lr < rpb) { const int r = rbase + lr, itr = 2 * g + q;
                        const int me = lane >> 1; float lg = br_[me];
#pragma unroll
                        for (int w2 = 0; w2 < 8; ++w2) lg += part[(w2 * 16 + 2 * wave + q) * 32 + me];
                        float tv[4]; int te[4];
                        unsigned key; { const unsigned ub = __float_as_uint(lg); key = (((ub & 0x80000000u) ? ~ub : (ub | 0x80000000u)) & ~31u) | (unsigned)(31 - me); }
                        int rank = 0;
#pragma unroll
                        for (int j2 = 0; j2 < 32; ++j2) { const unsigned kj = (unsigned)__builtin_amdgcn_readlane((int)key, 2 * j2); rank += (kj > key) ? 1 : 0; }
#pragma unroll
                        for (int k = 0; k < 4; ++k) { const unsigned long long hit = __ballot(rank == k); const int src = __builtin_amdgcn_readfirstlane((int)__builtin_ctzll(hit));
                            te[k] = src >> 1; tv[k] = __uint_as_float((unsigned)__builtin_amdgcn_readlane((int)__float_as_uint(lg), src)); }
                        const float e1 = __expf(tv[1] - tv[0]), e2 = __expf(tv[2] - tv[0]), e3 = __expf(tv[3] - tv[0]); const float inv = 1.0f / (1.0f + e1 + e2 + e3);
                        if (lane < 4) { const int e = lane == 0 ? te[0] : lane == 1 ? te[1] : lane == 2 ? te[2] : te[3]; const float gt = (lane == 0 ? 1.0f : lane == 1 ? e1 : lane == 2 ? e2 : e3) * inv;
                            const unsigned lr2 = __hip_atomic_fetch_add(lcount + e, 1u, __ATOMIC_RELAXED, __HIP_MEMORY_SCOPE_WORKGROUP);
                            lslot[(itr * NWAVES + wave) * 4 + lane] = (unsigned)e | (lr2 << 8); TIu[((size_t)r * 4 + lane) * 2 + 1] = __float_as_uint(gt); } } }
            }
#undef RT_ISSUE
            __syncthreads();
            if (tid < 32) lbase[tid] = __hip_atomic_fetch_add(cnt + tid, lcount[tid], __ATOMIC_RELAXED, __HIP_MEMORY_SCOPE_AGENT);
            __syncthreads();
            for (int itr = 0; itr < 2 * ngr; ++itr) { const int lr = 16 * (itr >> 1) + 2 * wave + (itr & 1), r = rbase + lr;
                if (lr < rpb && lane < 4) { const unsigned pk = lslot[(itr * NWAVES + wave) * 4 + lane]; const int e = pk & 255; const unsigned rank = lbase[e] + (pk >> 8);
                    LIST[(size_t)e * CAP + rank] = r; TIu[((size_t)r * 4 + lane) * 2] = (unsigned)e | (rank << 8); }
            }
        }
        SEAM(sb + 1);
        if (IN(sb + 2) || IN(sb + 3) || IN(sb + 4)) {
            __syncthreads();
            if (tid == 0) { const unsigned* cnt = ctl + CW_CNT + l * 32; int acc = 0;
                for (int e = 0; e < 32; ++e) { const int c = (int)__hip_atomic_load(cnt + e, __ATOMIC_RELAXED, __HIP_MEMORY_SCOPE_AGENT); l_cnt[e] = c; l_tp[e] = acc; acc += (c + 255) >> 8; }
                l_tp[32] = acc; }
            __syncthreads();
        }
        if (IN(sb + 2)) {
            pg8::MoeOrder S{l_tp, 8, G, bx, 0}; pg8::MoeGuAB8 am{(const unsigned char*)H, (const unsigned char*)WGU + (size_t)l * 32 * 2048 * 1024, LIST, l_tp, l_cnt}; pg8::EpiGU8 E{(unsigned char*)ACT, args.in[I_BGU] + (size_t)l * 32 * 2048};
            pg8::gemm_phase_f8<pg8::EpiGU8, pg8::MoeOrder, pg8::MoeGuAB8>(lds, S, E, am);
        }
        SEAM(sb + 2);
        if (IN(sb + 3)) {
            pg8::MoeOrder S{l_tp, 4, G, bx, 1}; pg8::MoeDnAB8 am{(const unsigned char*)ACT, (const unsigned char*)WDN + (size_t)l * 32 * 1024 * 1024}; pg8::EpiDn8 E{Y, args.in[I_BDN] + (size_t)l * 32 * 1024};
            pg8::gemm_phase_f8<pg8::EpiDn8, pg8::MoeOrder, pg8::MoeDnAB8>(lds, S, E, am);
        }
        SEAM(sb + 3);
        if (IN(sb + 4)) { FRESH_IDS
            const float* lng = args.in[I_LNG] + (size_t)(l * 2 + 1) * D; const float* lnb = args.in[I_LNB] + (size_t)(l * 2 + 1) * D;
            const int rpw = nrows / NGW, rbeg = gw * rpw, rend = rbeg + rpw, h0 = (rpw + 1) >> 1;
            f32x4 lngv[4], lnbv[4], g2v[4], shv[4], scv[4]; int cur_bb = -1;
#pragma unroll
            for (int j = 0; j < 4; ++j) { const int c = 4 * lane + 256 * j; lngv[j] = *(const f32x4*)(lng + c); lnbv[j] = *(const f32x4*)(lnb + c); shv[j] = (f32x4){0.f, 0.f, 0.f, 0.f}; scv[j] = shv[j]; }
            v2u tin[2][4]; int yn[2][4][4]; v2u xn[2][4]; float gtn[2][4];
#define CB_TI(q, rr) do { _Pragma("unroll") for (int k = 0; k < 4; ++k) tin[q][k] = TI[(size_t)(rr) * 4 + k]; } while (0)
#define CB_DATA(q, rr) do { const int r_ = (rr); _Pragma("unroll") for (int k = 0; k < 4; ++k) { const unsigned t0_ = tin[q][k].x, t1_ = tin[q][k].y; const int e_ = t0_ & 255, rank_ = t0_ >> 8; \
                    const unsigned char* yr_ = (const unsigned char*)Y + ((size_t)l_tp[e_] * 256 + rank_) * D; gtn[q][k] = __uint_as_float(t1_); \
                    _Pragma("unroll") for (int j = 0; j < 4; ++j) yn[q][k][j] = __builtin_nontemporal_load((const int*)(yr_ + 4 * lane + 256 * j)); } \
                _Pragma("unroll") for (int j = 0; j < 4; ++j) xn[q][j] = __builtin_nontemporal_load((const v2u*)(XL + (size_t)r_ * D + 4 * lane + 256 * j)); } while (0)
#pragma unroll
            for (int q = 0; q < 2; ++q) { const int r0 = rbeg + q * h0, re = q ? rend : rbeg + h0; if (r0 < re) { CB_TI(q, r0); CB_DATA(q, r0); if (r0 + 1 < re) CB_TI(q, r0 + 1); } }
            for (int it = 0; it < h0; ++it) {
#pragma unroll
              for (int q = 0; q < 2; ++q) {
                const int r = rbeg + q * h0 + it, re = q ? rend : rbeg + h0;
                if (r < re) {
                const int bb = r < TL ? (r >> 13) : 8;
                if (bb != cur_bb) { cur_bb = bb; const float* md = MOD + ((size_t)l * 9 + bb) * 6144; const float* md1 = MOD + ((size_t)9 + bb) * 6144;
#pragma unroll
                    for (int j = 0; j < 4; ++j) { const int c = 4 * lane + 256 * j; g2v[j] = *(const f32x4*)(md + 5120 + c); if (l == 0) { shv[j] = *(const f32x4*)(md1 + c); scv[j] = *(const f32x4*)(md1 + 1024 + c); } } }
                int yc[4][4]; v2u xc[4]; float gt[4];
#pragma unroll
                for (int k = 0; k < 4; ++k) { gt[k] = gtn[q][k];
#pragma unroll
                    for (int j = 0; j < 4; ++j) yc[k][j] = yn[q][k][j]; }
#pragma unroll
                for (int j = 0; j < 4; ++j) xc[j] = xn[q][j];
                if (r + 1 < re) { CB_DATA(q, r + 1); if (r + 2 < re) CB_TI(q, r + 2); }
                f32x4 v[4]; float s = 0.f;
#pragma unroll
                for (int j = 0; j < 4; ++j) { const v2u xx = xc[j]; const f32x4 xv = {bflo(xx.x), bfhi(xx.x), bflo(xx.y), bfhi(xx.y)};
                    f32x4 f = {0.f, 0.f, 0.f, 0.f};
#pragma unroll
                    for (int k = 0; k < 4; ++k) { const int yy = yc[k][j]; const f32x2 lo = __builtin_amdgcn_cvt_pk_f32_fp8(yy, false), hi = __builtin_amdgcn_cvt_pk_f32_fp8(yy, true); const f32x4 y4 = {lo[0], lo[1], hi[0], hi[1]}; f += y4 * gt[k]; }
                    v[j] = xv * DN_ALPHA + g2v[j] * f; s += (v[j][0] + v[j][1]) + (v[j][2] + v[j][3]); }
                const float mean = wave_sum(s) * (1.0f / D); float s2 = 0.f;
#pragma unroll
                for (int j = 0; j < 4; ++j) { v[j] = v[j] - mean; s2 += (v[j][0] * v[j][0] + v[j][1] * v[j][1]) + (v[j][2] * v[j][2] + v[j][3] * v[j][3]); }
                const float rstd = rsqrtf(wave_sum(s2) * (1.0f / D) + LN_EPS);
#pragma unroll
                for (int j = 0; j < 4; ++j) { const int c = 4 * lane + 256 * j;
                    const f32x4 y = v[j] * rstd * lngv[j] + lnbv[j];
                    if (l == 0) { { v2u xo; xo.x = pk2(y[0], y[1]); xo.y = pk2(y[2], y[3]); __builtin_nontemporal_store(xo, (v2u*)(XL + (size_t)r * D + c)); }
                        const f32x4 hv = y * (scv[j] + 1.0f) + shv[j]; *(unsigned*)((unsigned char*)H + (size_t)r * D + c) = pg8::pk4_fp8(hv[0], hv[1], hv[2], hv[3]); }
                    else {
                        __builtin_nontemporal_store(y, (f32x4*)(args.out + (size_t)r * D + c));
                    } }
                } }
            }
#undef CB_TI
#undef CB_DATA
        }
        if (l == 0) SEAM(sb + 4);
    };
    layer_body(std::integral_constant<int, 0>{});
    layer_body(std::integral_constant<int, 1>{});
#undef IN
#undef SEAM
}

extern "C" void kernel_launch(void* const* d_in, const int* in_sizes, int n_in, void* d_out, int out_size, void* d_ws, size_t ws_size, hipStream_t stream) {
    static int grid = 0;
    if (grid == 0) {
        if (n_in != 22 || out_size != TL * D || ws_size < WS_END) { fprintf(stderr, "kernel_launch: unexpected sizes (n_in %d out %d ws %zu)\n", n_in, out_size, ws_size); grid = -1; return; }
        int dev = 0, cus = 0, per_cu = 0;
        if (hipGetDevice(&dev) != hipSuccess || hipDeviceGetAttribute(&cus, hipDeviceAttributeMultiprocessorCount, dev) != hipSuccess) { grid = -1; return; }
        if (hipFuncSetAttribute((const void*)fwd, hipFuncAttributeMaxDynamicSharedMemorySize, LDS_BYTES) != hipSuccess) { fprintf(stderr, "kernel_launch: hipFuncSetAttribute failed\n"); grid = -1; return; }
        if (hipOccupancyMaxActiveBlocksPerMultiprocessor(&per_cu, (const void*)fwd, NWAVES * 64, LDS_BYTES) != hipSuccess || per_cu < 1) fprintf(stderr, "kernel_launch: occupancy query says %d\n", per_cu);
        (void)hipGetLastError();
        grid = cus;
    }
    if (grid < 0) return;
    (void)hipMemsetAsync((char*)d_ws + WS_CTL, 0, CTL_ZERO_BYTES, stream);
    Args a{};
    for (int i = 0; i < 22; ++i) a.in[i] = (const float*)d_in[i];
    a.out = (float*)d_out; a.ws = (unsigned char*)d_ws;
    a.s_lo = 0; a.s_hi = 17;
    hipLaunchKernelGGL(fwd, dim3(grid), dim3(NWAVES * 64), LDS_BYTES, stream, a);
}
```

```cpp
#include <hip/hip_runtime.h>
#include <cstdio>
#include <cstdint>
#include <type_traits>

constexpr int D = 1024, NB = 8, SEQ = 8192, CTXL = 256;
constexpr int TL = NB * SEQ, TC = NB * CTXL, TT = TL + TC;
constexpr int NE = 32, CAP = TT;
constexpr int HGN = 5120, DAN = 3072;
constexpr float DN_ALPHA = 1.4142135623730951f;
constexpr float LN_EPS = 1e-5f, RMS_EPS = 1e-6f;
constexpr float LAM_INIT = 0.35550906759f;
constexpr float QSCALE = 0.125f * 1.4426950408889634f;
constexpr int NWAVES = 8;

constexpr size_t MiB = 1u << 20;
constexpr size_t WS_CTL = 0, CTL_ZERO_BYTES = 1 * MiB;
constexpr int CW_TMO = 0, CW_CODE = 1, CW_BAR = 4096, CW_CNT = 8192;
constexpr size_t WS_MOD = 64 * 1024;
constexpr size_t WS_TAB = 1 * MiB;
constexpr int TAB_COS = 0, TAB_SIN = 2048, TAB_LB = 4096, TAB_LAM = 6144;
constexpr size_t WS_TI = 2 * MiB;
constexpr size_t WS_LIST = 6 * MiB;
constexpr size_t WS_WHGIN = 32 * MiB, WS_WHGOUT = 42 * MiB, WS_WDAIN = 44 * MiB, WS_WDAOUT = 50 * MiB, WS_WGU = 52 * MiB, WS_WDN = 308 * MiB;
constexpr size_t WS_R1 = 436 * MiB, WS_R2 = 1096 * MiB, WS_R3 = 1640 * MiB, WS_END = 1904 * MiB;
constexpr size_t ROWB = 2048;
constexpr size_t WS_PROJ0 = WS_R1;
constexpr size_t WS_ACT = WS_R1;
constexpr size_t WS_QKV = WS_R1;
constexpr size_t WS_QK8 = WS_R1, WS_VB = WS_R1 + 132 * MiB, WS_VT8 = WS_R1 + 264 * MiB;
constexpr size_t WS_O = WS_R1 + 396 * MiB;
constexpr size_t WS_OF = WS_R2, WS_OB = WS_R2 + 132 * MiB, WS_ARO = WS_R2 + 264 * MiB, WS_ML = WS_R2 + 396 * MiB;
constexpr size_t WS_Y = WS_R2;
constexpr size_t WS_XL = WS_R3;

constexpr int RING_BYTES = 131072;
constexpr int MISC_OFF = RING_BYTES;
constexpr int LDS_BYTES = 147456;

#define GAS __attribute__((address_space(1)))
#define LAS __attribute__((address_space(3)))
typedef unsigned short u16;
typedef unsigned v4u __attribute__((ext_vector_type(4)));
typedef unsigned v2u __attribute__((ext_vector_type(2)));
typedef float f32x4 __attribute__((ext_vector_type(4)));
typedef float f32x2 __attribute__((ext_vector_type(2)));

__device__ __forceinline__ unsigned f2bf(float f) { unsigned u = __builtin_bit_cast(unsigned, f); return (u + 0x7fffu + ((u >> 16) & 1u)) >> 16; }
__device__ __forceinline__ unsigned pk2(float lo, float hi) { return f2bf(lo) | (f2bf(hi) << 16); }
__device__ __forceinline__ float bf2f(unsigned h) { return __builtin_bit_cast(float, h << 16); }
__device__ __forceinline__ float bflo(unsigned w) { return __builtin_bit_cast(float, w << 16); }
__device__ __forceinline__ float bfhi(unsigned w) { return __builtin_bit_cast(float, w & 0xffff0000u); }
__device__ __forceinline__ unsigned f2h(float f) { _Float16 h = (_Float16)f; return (unsigned)__builtin_bit_cast(unsigned short, h); }
__device__ __forceinline__ float h2f(unsigned h) { return (float)__builtin_bit_cast(_Float16, (unsigned short)h); }
__device__ __forceinline__ float sigmoidf_(float x) { return __builtin_amdgcn_rcpf(1.0f + __builtin_amdgcn_exp2f(x * -1.4426950408889634f)); }
__device__ __forceinline__ float wave_sum(float v) {
#pragma unroll
    for (int o = 1; o < 16; o <<= 1) v += __shfl_xor(v, o);
    { const auto s16 = __builtin_amdgcn_permlane16_swap(__float_as_uint(v), __float_as_uint(v), false, false); v = __uint_as_float(s16[0]) + __uint_as_float(s16[1]); }
    { const auto s32 = __builtin_amdgcn_permlane32_swap(__float_as_uint(v), __float_as_uint(v), false, false); v = __uint_as_float(s32[0]) + __uint_as_float(s32[1]); }
    return v;
}

namespace pg8 {
#define PG8_LAS __attribute__((address_space(3)))
typedef unsigned short bf16_t;
typedef short bf16x8 __attribute__((ext_vector_type(8)));
typedef float f32x4 __attribute__((ext_vector_type(4)));
typedef unsigned u32x4 __attribute__((ext_vector_type(4)));
typedef unsigned u32x2 __attribute__((ext_vector_type(2)));
constexpr int BM = 256, BK = 64, HALF = 128, HTB = HALF * BK * 2, STAGE_BYTES = 8 * HTB, NXCD = 8, WGM = 8, KD = 1024;

__host__ __device__ __forceinline__ int lds_byte(int r, int c) { const int st = (r >> 4) * 2 + (c >> 5), rr = r & 15, cc = c & 31, ob = rr * 64 + cc * 2; return st * 1024 + (ob ^ (((ob >> 9) & 1) << 5)); }
__host__ __device__ __forceinline__ void stage_rc(int b, int& R, int& C) { const int st = b / 1024, sb = b % 1024, swz = sb ^ (((sb >> 9) & 1) << 5); R = (st >> 1) * 16 + swz / 64; C = (st & 1) * 32 + (swz % 64) / 2; }
__host__ __device__ __forceinline__ int perm32(int rho) { const int n = rho >> 4, i = rho & 15; return 8 * (i >> 2) + 4 * n + (i & 3); }

struct Unit { int pm, pn, e; };

struct StaticOrder {
    int nM, nN, nwg, G, c;
    __device__ void init(int M, int N, int G_, int c_) { nM = M / BM; nN = N / BM; nwg = nM * nN; G = G_; c = c_; }
    __device__ bool next(int i, Unit& u) const {
        const long L = (long)i * G + c; if (L >= nwg) return false;
        int wgid = (int)L; { const int q = nwg / NXCD, r = nwg % NXCD, xcd = wgid % NXCD, off = wgid / NXCD; wgid = (xcd < r ? xcd * (q + 1) : r * (q + 1) + (xcd - r) * q) + off; }
        const int nig = WGM * nN, gid = wgid / nig, fm = gid * WGM, gsz = (nM - fm) < WGM ? (nM - fm) : WGM;
        u.pm = fm + ((wgid % nig) % gsz); u.pn = (wgid % nig) / gsz; u.e = 0; return true;
    }
};
struct MoeOrder {
    const PG8_LAS int* tp; int nct, G, c, rev;
    __device__ bool next(int i, Unit& u) const {
        int rt, ct, e = 0;
        if (G == 256) {
            const int x = c & 7, j = c >> 3, rpx = 32 / nct; int q = i * rpx + j / nct; ct = j % nct;
            int k = 0; e = rev ? x + 24 : x;
#pragma unroll 1
            for (; k < 4; ++k) { const int n = tp[e + 1] - tp[e]; if (q < n) break; q -= n; e += rev ? -8 : 8; }
            if (k == 4) return false;
            rt = rev ? tp[e + 1] - 1 - q : tp[e] + q; }
        else { const int total = tp[32] * nct; const long L = (long)i * G + c; if (L >= total) return false; rt = (int)L / nct; ct = (int)L % nct; if (rev) rt = tp[32] - 1 - rt;
#pragma unroll 1
            for (int j = 1; j < 32; ++j) e += (tp[j] <= rt) ? 1 : 0; }
        u.pm = __builtin_amdgcn_readfirstlane(rt); u.pn = __builtin_amdgcn_readfirstlane(ct); u.e = __builtin_amdgcn_readfirstlane(e); return true;
    }
};
struct DenseAB { const bf16_t* A; const bf16_t* Bt;
    __device__ __forceinline__ const char* a_base(const Unit& u) const { return (const char*)A + (size_t)u.pm * (BM * KD * 2); }
    __device__ __forceinline__ const char* b_base(const Unit& u) const { return (const char*)Bt + (size_t)u.pn * (BM * KD * 2); }
    __device__ __forceinline__ void a_offs(const Unit&, const int (&R)[2], const int (&C)[2], unsigned (&v)[2][2]) const {
#pragma unroll
        for (int h = 0; h < 2; ++h)
#pragma unroll
            for (int i = 0; i < 2; ++i) v[h][i] = (unsigned)((h * HALF + R[i]) * KD + C[i]) * 2u; }
};
struct MoeDnAB { const bf16_t* A; const bf16_t* Bt;
    __device__ __forceinline__ const char* a_base(const Unit& u) const { return (const char*)A + (size_t)u.pm * (BM * KD * 2); }
    __device__ __forceinline__ const char* b_base(const Unit& u) const { return (const char*)Bt + (size_t)u.e * (1024 * KD * 2) + (size_t)u.pn * (BM * KD * 2); }
    __device__ __forceinline__ void a_offs(const Unit&, const int (&R)[2], const int (&C)[2], unsigned (&v)[2][2]) const {
#pragma unroll
        for (int h = 0; h < 2; ++h)
#pragma unroll
            for (int i = 0; i < 2; ++i) v[h][i] = (unsigned)((h * HALF + R[i]) * KD + C[i]) * 2u; }
};
struct MoeGuAB { const bf16_t* A; const bf16_t* Bt; const int* list; const PG8_LAS int* tp; const PG8_LAS int* cnt;
    __device__ __forceinline__ const char* a_base(const Unit&) const { return (const char*)A; }
    __device__ __forceinline__ const char* b_base(const Unit& u) const { return (const char*)Bt + (size_t)u.e * (2048 * KD * 2) + (size_t)u.pn * (BM * KD * 2); }
    __device__ __forceinline__ void a_offs(const Unit& u, const int (&R)[2], const int (&C)[2], unsigned (&v)[2][2]) const {
        const int r0 = (u.pm - tp[u.e]) * BM, n = cnt[u.e];
#pragma unroll
        for (int h = 0; h < 2; ++h)
#pragma unroll
            for (int i = 0; i < 2; ++i) { const int rank = r0 + h * HALF + R[i]; int tok = list[(size_t)u.e * CAP + rank]; tok = rank < n ? tok : 0;
                v[h][i] = (unsigned)(tok * KD + C[i]) * 2u; } }
};

__device__ __forceinline__ unsigned cvt_pk_bf16(float lo, float hi) { unsigned r; asm volatile("v_cvt_pk_bf16_f32 %0, %1, %2" : "=v"(r) : "v"(lo), "v"(hi)); return r; }
__device__ __forceinline__ unsigned pk4_fp8(float a, float b, float c, float d);

struct EpiBf16 {
    static constexpr bool PERM = true;
    bf16_t* O; int ldc; const float* bias; int bias_stride; float ascale;
    __device__ __forceinline__ void operator()(const f32x4 (&acc)[2][2][4][2], const Unit& u, int wr, int wc, int fr, int fq) const {
        const int row0 = u.pm * BM + wr * 64 + fr, col0 = u.pn * BM + wc * 32 + 8 * fq;
        f32x4 bv[2][2];
#pragma unroll
        for (int bj = 0; bj < 2; ++bj)
#pragma unroll
            for (int n = 0; n < 2; ++n) bv[bj][n] = bias ? *(const f32x4*)(bias + (size_t)u.e * bias_stride + col0 + bj * HALF + 4 * n) : (f32x4){0.f, 0.f, 0.f, 0.f};
#pragma unroll
        for (int ai = 0; ai < 2; ++ai)
#pragma unroll
            for (int m = 0; m < 4; ++m) { bf16_t* rowp = O + (size_t)(row0 + ai * HALF + m * 16) * ldc + col0;
#pragma unroll
                for (int bj = 0; bj < 2; ++bj) { const f32x4 v0 = acc[ai][bj][m][0] * ascale + bv[bj][0], v1 = acc[ai][bj][m][1] * ascale + bv[bj][1];
                    u32x4 w; w.x = cvt_pk_bf16(v0[0], v0[1]); w.y = cvt_pk_bf16(v0[2], v0[3]); w.z = cvt_pk_bf16(v1[0], v1[1]); w.w = cvt_pk_bf16(v1[2], v1[3]);
                    *(u32x4*)(rowp + bj * HALF) = w; } }
    }
};
struct EpiHgProj {
    static constexpr bool PERM = true;
    bf16_t* P; const float* lb; float ascale;
    __device__ __forceinline__ void operator()(const f32x4 (&acc)[2][2][4][2], const Unit& u, int wr, int wc, int fr, int fq) const {
        const int row0 = u.pm * BM + wr * 64 + fr, col0 = u.pn * BM + wc * 32 + 8 * fq;
        const bool isz = (u.pn >= 12);
        f32x4 lbv[2][2];
#pragma unroll
        for (int bj = 0; bj < 2; ++bj)
#pragma unroll
            for (int n = 0; n < 2; ++n) lbv[bj][n] = isz ? *(const f32x4*)(lb + (col0 - 3072) + bj * HALF + 4 * n) : (f32x4){0.f, 0.f, 0.f, 0.f};
#pragma unroll
        for (int ai = 0; ai < 2; ++ai)
#pragma unroll
            for (int m = 0; m < 4; ++m) { bf16_t* rowp = P + (size_t)(row0 + ai * HALF + m * 16) * HGN + col0;
#pragma unroll
                for (int bj = 0; bj < 2; ++bj) { u32x4 w;
                    if (!isz) { const f32x4 v0 = acc[ai][bj][m][0] * ascale, v1 = acc[ai][bj][m][1] * ascale;
                        w.x = cvt_pk_bf16(v0[0], v0[1]); w.y = cvt_pk_bf16(v0[2], v0[3]); w.z = cvt_pk_bf16(v1[0], v1[1]); w.w = cvt_pk_bf16(v1[2], v1[3]); }
                    else { float lf[8];
#pragma unroll
                        for (int n = 0; n < 2; ++n)
#pragma unroll
                            for (int i = 0; i < 4; ++i) { const float z = acc[ai][bj][m][n][i] * ascale, l = lbv[bj][n][i]; const float f = l + (1.0f - l) * sigmoidf_(z); lf[n * 4 + i] = __builtin_amdgcn_logf(f); }
                        w.x = f2h(lf[0]) | (f2h(lf[1]) << 16); w.y = f2h(lf[2]) | (f2h(lf[3]) << 16); w.z = f2h(lf[4]) | (f2h(lf[5]) << 16); w.w = f2h(lf[6]) | (f2h(lf[7]) << 16); }
                    *(u32x4*)(rowp + bj * HALF) = w; } }
    }
};
struct EpiGU {
    static constexpr bool PERM = true;
    bf16_t* ACT; const float* bgu;
    __device__ __forceinline__ void operator()(const f32x4 (&acc)[2][2][4][2], const Unit& u, int wr, int wc, int fr, int fq) const {
        const int row0 = u.pm * BM + wr * 64 + fr, j0 = u.pn * HALF + wc * 32 + 8 * fq;
        const float* bg = bgu + (size_t)u.e * 2048 + j0;
        f32x4 bgv[2], buv[2];
#pragma unroll
        for (int n = 0; n < 2; ++n) { bgv[n] = *(const f32x4*)(bg + 4 * n); buv[n] = *(const f32x4*)(bg + 1024 + 4 * n); }
#pragma unroll
        for (int ai = 0; ai < 2; ++ai)
#pragma unroll
            for (int m = 0; m < 4; ++m) { float a[8];
#pragma unroll
                for (int n = 0; n < 2; ++n)
#pragma unroll
                    for (int i = 0; i < 4; ++i) { float g = acc[ai][0][m][n][i] + bgv[n][i], up = acc[ai][1][m][n][i] + buv[n][i];
                        g = fminf(g, 7.0f); up = fminf(fmaxf(up, -7.0f), 7.0f); a[n * 4 + i] = (up + 1.0f) * g * sigmoidf_(1.702f * g); }
                u32x4 w; w.x = cvt_pk_bf16(a[0], a[1]); w.y = cvt_pk_bf16(a[2], a[3]); w.z = cvt_pk_bf16(a[4], a[5]); w.w = cvt_pk_bf16(a[6], a[7]);
                *(u32x4*)(ACT + (size_t)(row0 + ai * HALF + m * 16) * 1024 + j0) = w; }
    }
};
struct EpiDaProj {
    static constexpr bool PERM = false;
    unsigned char* QK8; bf16_t* VB; const float* tab; float ascale;
    __device__ __forceinline__ void operator()(const f32x4 (&acc)[2][2][4][2], const Unit& u, int wr, int wc, int fr, int fq) const {
        const int row0 = u.pm * BM + wr * 64 + fr, col0 = u.pn * BM + wc * 32 + 4 * fq;
        const bool rot = (u.pn < 8) && (u.pm < TL / BM);
        const float sc = ((u.pn < 4) ? QSCALE : 1.0f) * ascale;
#pragma unroll
        for (int ai = 0; ai < 2; ++ai)
#pragma unroll
            for (int m = 0; m < 4; ++m) { const int row = row0 + ai * HALF + m * 16;
                f32x4 cs = {1.f, 1.f, 1.f, 1.f}, sn = {0.f, 0.f, 0.f, 0.f};
                if (rot) { const int t = row & (SEQ - 1); const int pos = (wc & 1) ? (t & 63) : (t >> 6); cs = *(const f32x4*)(tab + TAB_COS + pos * 16 + 4 * fq); sn = *(const f32x4*)(tab + TAB_SIN + pos * 16 + 4 * fq); }
#pragma unroll
                for (int bj = 0; bj < 2; ++bj) { const f32x4 u1 = acc[ai][bj][m][0], u2 = acc[ai][bj][m][1];
                    const f32x4 o1 = (u1 * cs - u2 * sn) * sc, o2 = (u1 * sn + u2 * cs) * sc;
                    if (u.pn < 8) { unsigned char* p = QK8 + (size_t)row * 2048 + col0 + bj * HALF; *(unsigned*)p = pk4_fp8(o1[0], o1[1], o1[2], o1[3]); *(unsigned*)(p + 16) = pk4_fp8(o2[0], o2[1], o2[2], o2[3]); }
                    else { unsigned char* p = (unsigned char*)VB + (size_t)row * 1024 + (col0 - 2048) + bj * HALF; *(unsigned*)p = pk4_fp8(o1[0], o1[1], o1[2], o1[3]); *(unsigned*)(p + 16) = pk4_fp8(o2[0], o2[1], o2[2], o2[3]); } }
                asm volatile("" ::: "memory"); }
    }
};

template <class Epi, class Sched, class AM, bool ALIGN_EPI, bool SP2>
__device__ __forceinline__ void gemm_phase(PG8_LAS unsigned char* lds, const Sched& S, const Epi& E, const AM& am) {
    int tid = threadIdx.x; asm volatile("" : "+v"(tid));
    const int wid = __builtin_amdgcn_readfirstlane(tid >> 6), lane = tid & 63, wr = wid >> 2, wc = wid & 3, fr = lane & 15, fq = lane >> 4;
    constexpr int K = KD, nt = K / BK;
    int sR[2], sC[2]; unsigned voffB[2][2];
#pragma unroll
    for (int i = 0; i < 2; ++i) { stage_rc(tid * 16 + i * 8192, sR[i], sC[i]); const int Rb = Epi::PERM ? ((sR[i] & ~31) + perm32(sR[i] & 31)) : sR[i];
        voffB[0][i] = (unsigned)(Rb * K + sC[i]) * 2u; voffB[1][i] = voffB[0][i] + (unsigned)(HALF * K * 2); }
    const size_t kstep = (size_t)(BK * 2);
    const unsigned ldsw = (unsigned)wid * 1024u;
    const int aoff = lds_byte(wr * 64 + fr, fq * 8), boff = lds_byte(wc * 32 + fr, fq * 8);
#define PG8_SA(b, h) (((b) * 2 + (h)) * HTB)
#define PG8_SB(b, h) ((4 + (b) * 2 + (h)) * HTB)
#define PG8_STAGE(bufoff, gbase, voff) do { _Pragma("unroll") for (int _i = 0; _i < 2; ++_i) \
        __builtin_amdgcn_global_load_lds((const unsigned*)((const char*)(gbase) + (voff)[_i]), (PG8_LAS unsigned*)(lds + (bufoff) + ldsw + _i * 8192), 16, 0, 0); } while (0)
#define PG8_LDA(dst, b, h) do { _Pragma("unroll") for (int m = 0; m < 4; ++m) _Pragma("unroll") for (int k = 0; k < 2; ++k) dst[m][k] = *(const PG8_LAS bf16x8*)(lds + PG8_SA(b, h) + aoff + m * 2048 + k * 1024); } while (0)
#define PG8_LDB(dst, b, h) do { _Pragma("unroll") for (int n = 0; n < 2; ++n) _Pragma("unroll") for (int k = 0; k < 2; ++k) dst[n][k] = *(const PG8_LAS bf16x8*)(lds + PG8_SB(b, h) + boff + n * 2048 + k * 1024); } while (0)
#define PG8_MMA(ai, bj, At, Bt) do { __builtin_amdgcn_s_setprio(1); _Pragma("unroll") for (int m = 0; m < 4; ++m) _Pragma("unroll") for (int n = 0; n < 2; ++n) _Pragma("unroll") for (int k = 0; k < 2; ++k) \
        acc[ai][bj][m][n] = __builtin_amdgcn_mfma_f32_16x16x32_bf16(Bt[n][k], At[m][k], acc[ai][bj][m][n], 0, 0, 0); __builtin_amdgcn_s_setprio(0); } while (0)
#define PG8_WAIT_V(n) asm volatile("s_waitcnt vmcnt(" #n ")" ::: "memory")
#define PG8_WAIT_L(n) asm volatile("s_waitcnt lgkmcnt(" #n ")" ::: "memory")
#define PG8_BAR __builtin_amdgcn_s_barrier()
#define PG8_SCHED __builtin_amdgcn_sched_barrier(0)
    Unit cur, nxt; int ui = 0;
    if (!S.next(0, cur)) return;
    f32x4 acc[2][2][4][2];
#pragma unroll
    for (int a = 0; a < 2; ++a)
#pragma unroll
        for (int b = 0; b < 2; ++b)
#pragma unroll
            for (int m = 0; m < 4; ++m)
#pragma unroll
                for (int n = 0; n < 2; ++n) acc[a][b][m][n] = (f32x4){0.f, 0.f, 0.f, 0.f};
    bf16x8 At[4][2], B0[2][2], B1[2][2];
    unsigned vAc[2][2], vAn[2][2];
    am.a_offs(cur, sR, sC, vAc);
    const char* cA = am.a_base(cur); const char* cB = am.b_base(cur);
    if constexpr (SP2) {
        PG8_STAGE(PG8_SB(0, 0), cB, voffB[0]); PG8_STAGE(PG8_SB(0, 1), cB, voffB[1]); PG8_STAGE(PG8_SA(0, 0), cA, vAc[0]); PG8_STAGE(PG8_SA(0, 1), cA, vAc[1]);
        if (wr == 1) PG8_BAR;
        PG8_WAIT_V(2); PG8_BAR;
        PG8_STAGE(PG8_SB(1, 0), cB + kstep, voffB[0]); PG8_STAGE(PG8_SA(1, 0), cA + kstep, vAc[0]); PG8_STAGE(PG8_SB(1, 1), cB + kstep, voffB[1]);
        PG8_WAIT_V(6); PG8_BAR;
    } else {
        PG8_STAGE(PG8_SB(0, 0), cB, voffB[0]); PG8_STAGE(PG8_SA(0, 0), cA, vAc[0]); PG8_STAGE(PG8_SB(0, 1), cB, voffB[1]); PG8_STAGE(PG8_SA(0, 1), cA, vAc[1]);
        if (wr == 1) PG8_BAR;
        PG8_WAIT_V(4); PG8_BAR;
        PG8_STAGE(PG8_SB(1, 0), cB + kstep, voffB[0]); PG8_STAGE(PG8_SA(1, 0), cA + kstep, vAc[0]); PG8_STAGE(PG8_SB(1, 1), cB + kstep, voffB[1]);
        PG8_WAIT_V(6); PG8_BAR;
    }
    for (;;) {
        const bool has_next = S.next(ui + 1, nxt);
        const char* nA = cA; const char* nB = cB;
#pragma unroll
        for (int h = 0; h < 2; ++h)
#pragma unroll
            for (int i = 0; i < 2; ++i) vAn[h][i] = vAc[h][i];
        if (has_next) { nA = am.a_base(nxt); nB = am.b_base(nxt); am.a_offs(nxt, sR, sC, vAn); }
        for (int t = 0; t < nt; t += 2) {
            const bool last = (t == nt - 2);
            const char* a1 = cA + (size_t)(t + 1) * kstep;
            const char* a2 = last ? nA : cA + (size_t)(t + 2) * kstep; const char* b2 = last ? nB : cB + (size_t)(t + 2) * kstep;
            const char* a3 = a2 + kstep; const char* b3 = b2 + kstep;
            unsigned vA2[2][2];
#pragma unroll
            for (int h = 0; h < 2; ++h)
#pragma unroll
                for (int i = 0; i < 2; ++i) vA2[h][i] = last ? vAn[h][i] : vAc[h][i];
            if constexpr (SP2) {
            PG8_LDB(B0, 0, 0); PG8_LDB(B1, 0, 1); PG8_SCHED; PG8_LDA(At, 0, 0); PG8_STAGE(PG8_SA(1, 1), a1, vAc[1]);
            PG8_WAIT_V(8); PG8_WAIT_L(0); PG8_BAR; PG8_MMA(0, 0, At, B0); PG8_MMA(0, 1, At, B1); PG8_BAR; PG8_SCHED;
            PG8_LDA(At, 0, 1); PG8_STAGE(PG8_SB(0, 0), b2, voffB[0]); PG8_STAGE(PG8_SB(0, 1), b2, voffB[1]); PG8_STAGE(PG8_SA(0, 0), a2, vA2[0]);
            PG8_WAIT_V(8); PG8_WAIT_L(0); PG8_BAR; PG8_MMA(1, 0, At, B0); PG8_MMA(1, 1, At, B1); PG8_BAR; PG8_SCHED;
            PG8_LDB(B0, 1, 0); PG8_LDB(B1, 1, 1); PG8_SCHED; PG8_LDA(At, 1, 0); PG8_STAGE(PG8_SA(0, 1), a2, vA2[1]);
            PG8_WAIT_V(8); PG8_WAIT_L(0); PG8_BAR; PG8_MMA(0, 0, At, B0); PG8_MMA(0, 1, At, B1); PG8_BAR; PG8_SCHED;
            PG8_LDA(At, 1, 1); PG8_STAGE(PG8_SB(1, 0), b3, voffB[0]); PG8_STAGE(PG8_SB(1, 1), b3, voffB[1]); PG8_STAGE(PG8_SA(1, 0), a3, vA2[0]);
            PG8_WAIT_V(8); PG8_WAIT_L(0); PG8_BAR; PG8_MMA(1, 0, At, B0); PG8_MMA(1, 1, At, B1); PG8_BAR; PG8_SCHED;
            } else {
            PG8_LDB(B0, 0, 0); PG8_SCHED; PG8_LDA(At, 0, 0); PG8_STAGE(PG8_SA(1, 1), a1, vAc[1]);
            PG8_WAIT_L(8); PG8_BAR; PG8_WAIT_L(0); PG8_MMA(0, 0, At, B0); PG8_BAR; PG8_SCHED;
            PG8_LDB(B1, 0, 1); PG8_STAGE(PG8_SB(0, 0), b2, voffB[0]);
            PG8_BAR; PG8_WAIT_L(0); PG8_MMA(0, 1, At, B1); PG8_BAR;
            PG8_LDA(At, 0, 1); PG8_STAGE(PG8_SA(0, 0), a2, vA2[0]);
            PG8_BAR; PG8_WAIT_L(0); PG8_MMA(1, 0, At, B0); PG8_BAR; PG8_SCHED;
            PG8_STAGE(PG8_SB(0, 1), b2, voffB[1]);
            PG8_WAIT_V(6); PG8_BAR; PG8_MMA(1, 1, At, B1); PG8_BAR;
            PG8_LDB(B0, 1, 0); PG8_SCHED; PG8_LDA(At, 1, 0); PG8_STAGE(PG8_SA(0, 1), a2, vA2[1]);
            PG8_WAIT_L(8); PG8_BAR; PG8_WAIT_L(0); PG8_MMA(0, 0, At, B0); PG8_BAR; PG8_SCHED;
            PG8_LDB(B1, 1, 1); PG8_STAGE(PG8_SB(1, 0), b3, voffB[0]);
            PG8_BAR; PG8_WAIT_L(0); PG8_MMA(0, 1, At, B1); PG8_BAR;
            PG8_LDA(At, 1, 1); PG8_STAGE(PG8_SA(1, 0), a3, vA2[0]);
            PG8_BAR; PG8_WAIT_L(0); PG8_MMA(1, 0, At, B0); PG8_BAR; PG8_SCHED;
            PG8_STAGE(PG8_SB(1, 1), b3, voffB[1]);
            PG8_WAIT_V(6); PG8_BAR; PG8_MMA(1, 1, At, B1); PG8_BAR;
            }
        }
        if constexpr (ALIGN_EPI) { if (wr == 0) PG8_BAR; }
        { int fr2 = fr, fq2 = fq; asm volatile("" : "+v"(fr2), "+v"(fq2)); E(acc, cur, wr, wc, fr2, fq2); }
        if (!has_next) break;
#pragma unroll
        for (int a = 0; a < 2; ++a)
#pragma unroll
            for (int b = 0; b < 2; ++b)
#pragma unroll
                for (int m = 0; m < 4; ++m)
#pragma unroll
                    for (int n = 0; n < 2; ++n) acc[a][b][m][n] = (f32x4){0.f, 0.f, 0.f, 0.f};
        cur = nxt; cA = nA; cB = nB; ++ui;
#pragma unroll
        for (int h = 0; h < 2; ++h)
#pragma unroll
            for (int i = 0; i < 2; ++i) vAc[h][i] = vAn[h][i];
        if constexpr (ALIGN_EPI) { if (wr == 1) PG8_BAR; }
    }
    PG8_WAIT_V(0);
    if constexpr (!ALIGN_EPI) { if (wr == 0) PG8_BAR; }
    PG8_BAR;
#undef PG8_SA
#undef PG8_SB
#undef PG8_STAGE
#undef PG8_LDA
#undef PG8_LDB
#undef PG8_MMA
#undef PG8_WAIT_V
#undef PG8_WAIT_L
#undef PG8_BAR
#undef PG8_SCHED
}

typedef int i32x8 __attribute__((ext_vector_type(8)));
constexpr int RSB8 = 1024, NT8 = 8;
__host__ __device__ __forceinline__ int f8swz(int rr) { return ((rr >> 1) & 1) ^ (((rr >> 3) & 1) << 2); }
struct MoeGuAB8 { const unsigned char* A; const unsigned char* Bt; const int* list; const PG8_LAS int* tp; const PG8_LAS int* cnt;
    __device__ __forceinline__ const char* a_base(const Unit&) const { return (const char*)A; }
    __device__ __forceinline__ const char* b_base(const Unit& u) const { return (const char*)Bt + (size_t)u.e * (2048 * RSB8) + (size_t)u.pn * (BM * RSB8); }
    __device__ __forceinline__ void a_offs(const Unit& u, const int (&R)[2], const int (&Cb)[2], unsigned (&v)[2][2]) const {
        const int r0 = (u.pm - tp[u.e]) * BM, n = cnt[u.e];
#pragma unroll
        for (int h = 0; h < 2; ++h)
#pragma unroll
            for (int i = 0; i < 2; ++i) { const int rank = r0 + h * HALF + R[i]; int tok = list[(size_t)u.e * CAP + rank]; tok = rank < n ? tok : 0;
                v[h][i] = (unsigned)(tok * RSB8 + Cb[i]); } }
};
struct DenseAB8 { const unsigned char* A; const unsigned char* Bt;
    __device__ __forceinline__ const char* a_base(const Unit& u) const { return (const char*)A + (size_t)u.pm * (BM * RSB8); }
    __device__ __forceinline__ const char* b_base(const Unit& u) const { return (const char*)Bt + (size_t)u.pn * (BM * RSB8); }
    __device__ __forceinline__ void a_offs(const Unit&, const int (&R)[2], const int (&Cb)[2], unsigned (&v)[2][2]) const {
#pragma unroll
        for (int h = 0; h < 2; ++h)
#pragma unroll
            for (int i = 0; i < 2; ++i) v[h][i] = (unsigned)((h * HALF + R[i]) * RSB8 + Cb[i]); }
};
struct MoeDnAB8 { const unsigned char* A; const unsigned char* Bt;
    __device__ __forceinline__ const char* a_base(const Unit& u) const { return (const char*)A + (size_t)u.pm * (BM * RSB8); }
    __device__ __forceinline__ const char* b_base(const Unit& u) const { return (const char*)Bt + (size_t)u.e * (1024 * RSB8) + (size_t)u.pn * (BM * RSB8); }
    __device__ __forceinline__ void a_offs(const Unit&, const int (&R)[2], const int (&Cb)[2], unsigned (&v)[2][2]) const {
#pragma unroll
        for (int h = 0; h < 2; ++h)
#pragma unroll
            for (int i = 0; i < 2; ++i) v[h][i] = (unsigned)((h * HALF + R[i]) * RSB8 + Cb[i]); }
};
__device__ __forceinline__ unsigned pk4_fp8(float a, float b, float c, float d) { int w = __builtin_amdgcn_cvt_pk_fp8_f32(a, b, 0, false); w = __builtin_amdgcn_cvt_pk_fp8_f32(c, d, w, true); return (unsigned)w; }
struct EpiGU8 {
    static constexpr bool PERM = true;
    unsigned char* ACT; const float* bgu;
    __device__ __forceinline__ void operator()(const f32x4 (&acc)[2][2][4][2], const Unit& u, int wr, int wc, int fr, int fq) const {
        const int row0 = u.pm * BM + wr * 64 + fr, j0 = u.pn * HALF + wc * 32 + 8 * fq;
        const float* bg = bgu + (size_t)u.e * 2048 + j0;
        f32x4 bgv[2], buv[2];
#pragma unroll
        for (int n = 0; n < 2; ++n) { bgv[n] = *(const f32x4*)(bg + 4 * n); buv[n] = *(const f32x4*)(bg + 1024 + 4 * n) + 1.0f; }
        const int jw = u.pn * HALF + wc * 32 + 16 * (fq >> 1);
#pragma unroll
        for (int ai = 0; ai < 2; ++ai) { u32x2 wv[4];
#pragma unroll
            for (int m = 0; m < 4; ++m) { float a[8];
#pragma unroll
                for (int n = 0; n < 2; ++n)
#pragma unroll
                    for (int i = 0; i < 4; ++i) { float g = acc[ai][0][m][n][i] * (1.0f / 32.0f) + bgv[n][i], u1 = acc[ai][1][m][n][i] * (1.0f / 32.0f) + buv[n][i];
                        g = fminf(g, 7.0f); u1 = __builtin_amdgcn_fmed3f(u1, -6.0f, 8.0f);
                        const float sg_ = __builtin_amdgcn_rcpf(1.0f + __builtin_amdgcn_exp2f(g * (-1.702f * 1.4426950408889634f)));
                        a[n * 4 + i] = u1 * g * sg_; }
                wv[m].x = pk4_fp8(a[0], a[1], a[2], a[3]); wv[m].y = pk4_fp8(a[4], a[5], a[6], a[7]);
                if (m & 1) {
                    const auto sx = __builtin_amdgcn_permlane16_swap(wv[m - 1].x, wv[m].x, false, false); const auto sy = __builtin_amdgcn_permlane16_swap(wv[m - 1].y, wv[m].y, false, false);
                    *(u32x4*)(ACT + (size_t)(row0 + ai * HALF + (m - 1 + (fq & 1)) * 16) * 1024 + jw) = (u32x4){sx[0], sy[0], sx[1], sy[1]}; } } }
    }
};
struct EpiDn8 {
    static constexpr bool PERM = true;
    bf16_t* O; const float* bias;
    __device__ __forceinline__ void operator()(const f32x4 (&acc)[2][2][4][2], const Unit& u, int wr, int wc, int fr, int fq) const {
        const int row0 = u.pm * BM + wr * 64 + fr, col0 = u.pn * BM + wc * 32 + 8 * fq;
        f32x4 bv[2][2];
#pragma unroll
        for (int bj = 0; bj < 2; ++bj)
#pragma unroll
            for (int n = 0; n < 2; ++n) bv[bj][n] = *(const f32x4*)(bias + (size_t)u.e * 1024 + col0 + bj * HALF + 4 * n);
        const int cw = u.pn * BM + wc * 32 + 16 * (fq >> 1);
#pragma unroll
        for (int ai = 0; ai < 2; ++ai) { u32x2 wv[4][2];
#pragma unroll
            for (int m = 0; m < 4; ++m) {
#pragma unroll
                for (int bj = 0; bj < 2; ++bj) { const f32x4 v0 = acc[ai][bj][m][0] * (1.0f / 64.0f) + bv[bj][0], v1 = acc[ai][bj][m][1] * (1.0f / 64.0f) + bv[bj][1];
                    wv[m][bj].x = pk4_fp8(v0[0], v0[1], v0[2], v0[3]); wv[m][bj].y = pk4_fp8(v1[0], v1[1], v1[2], v1[3]);
                    if (m & 1) {
                        const auto sx = __builtin_amdgcn_permlane16_swap(wv[m - 1][bj].x, wv[m][bj].x, false, false); const auto sy = __builtin_amdgcn_permlane16_swap(wv[m - 1][bj].y, wv[m][bj].y, false, false);
                        *(u32x4*)((unsigned char*)O + (size_t)(row0 + ai * HALF + (m - 1 + (fq & 1)) * 16) * 1024 + cw + bj * HALF) = (u32x4){sx[0], sy[0], sx[1], sy[1]}; } } } }
    }
};
template <class Epi, class Sched, class AM>
__device__ __forceinline__ void gemm_phase_f8(PG8_LAS unsigned char* lds, const Sched& S, const Epi& E, const AM& am) {
    int tid = threadIdx.x; asm volatile("" : "+v"(tid));
    const int wid = __builtin_amdgcn_readfirstlane(tid >> 6), lane = tid & 63, wr = wid >> 2, wc = wid & 3, fr = lane & 15, fq = lane >> 4;
    constexpr int nt = NT8;
#define PG8_GEOM(sR, sCb) int sR[2], sCb[2]; { int l_ = threadIdx.x & 63; asm volatile("" : "+v"(l_)); _Pragma("unroll") for (int i = 0; i < 2; ++i) { sR[i] = (wid + 8 * i) * 8 + (l_ >> 3); sCb[i] = ((l_ & 7) ^ f8swz(sR[i] & 15)) * 16; } }
#define PG8_VOFFB(v, h) unsigned v[2]; { PG8_GEOM(r_, c_); _Pragma("unroll") for (int i = 0; i < 2; ++i) { const int Rb_ = Epi::PERM ? ((r_[i] & ~31) + perm32(r_[i] & 31)) : r_[i]; v[i] = (unsigned)(((h) * HALF + Rb_) * RSB8 + c_[i]); } }
    const size_t kstep = 128;
    const unsigned ldsw = (unsigned)wid * 1024u;
    const int aoff0 = (wr * 64 + fr) * 128 + ((2 * fq) ^ f8swz(fr)) * 16, boff0 = (wc * 32 + fr) * 128 + ((2 * fq) ^ f8swz(fr)) * 16;
#define PG8_SA(b, h) (((b) * 2 + (h)) * HTB)
#define PG8_SB(b, h) ((4 + (b) * 2 + (h)) * HTB)
#define PG8_STAGE(bufoff, gbase, voff) do { _Pragma("unroll") for (int _i = 0; _i < 2; ++_i) \
        __builtin_amdgcn_global_load_lds((const unsigned*)((const char*)(gbase) + (voff)[_i]), (PG8_LAS unsigned*)(lds + (bufoff) + ldsw + _i * 8192), 16, 0, 0); } while (0)
#define PG8_LD2(dst, off0, off1) do { const u32x4 lo_ = *(const PG8_LAS u32x4*)(lds + (off0)), hi_ = *(const PG8_LAS u32x4*)(lds + (off1)); dst = (i32x8){(int)lo_.x, (int)lo_.y, (int)lo_.z, (int)lo_.w, (int)hi_.x, (int)hi_.y, (int)hi_.z, (int)hi_.w}; } while (0)
#define PG8_LDA(dst, b, h) do { _Pragma("unroll") for (int m = 0; m < 4; ++m) PG8_LD2(dst[m], PG8_SA(b, h) + aoff0 + m * 2048, PG8_SA(b, h) + (aoff0 ^ 16) + m * 2048); } while (0)
#define PG8_LDB(dst, b, h) do { _Pragma("unroll") for (int n = 0; n < 2; ++n) PG8_LD2(dst[n], PG8_SB(b, h) + boff0 + n * 2048, PG8_SB(b, h) + (boff0 ^ 16) + n * 2048); } while (0)
#define PG8_MMA(ai, bj, At, Bt) do { __builtin_amdgcn_s_setprio(1); asm volatile("s_nop 1" ::: "memory"); _Pragma("unroll") for (int m = 0; m < 4; ++m) _Pragma("unroll") for (int n = 0; n < 2; ++n) \
        asm volatile("v_mfma_scale_f32_16x16x128_f8f6f4 %0, %1, %2, %0, %3, %3 op_sel_hi:[0,0,0]" : "+v"(acc[ai][bj][m][n]) : "v"(Bt[n]), "v"(At[m]), "v"(scale1)); __builtin_amdgcn_s_setprio(0); } while (0)
#define PG8_WAIT_V(n) asm volatile("s_waitcnt vmcnt(" #n ")" ::: "memory")
#define PG8_WAIT_L(n) asm volatile("s_waitcnt lgkmcnt(" #n ")" ::: "memory")
#define PG8_BAR __builtin_amdgcn_s_barrier()
#define PG8_SCHED __builtin_amdgcn_sched_barrier(0)
    const int scale1 = 0x7f7f7f7f;
    Unit cur, nxt; int ui = 0;
    if (!S.next(0, cur)) return;
    f32x4 acc[2][2][4][2];
#pragma unroll
    for (int a = 0; a < 2; ++a)
#pragma unroll
        for (int b = 0; b < 2; ++b)
#pragma unroll
            for (int m = 0; m < 4; ++m)
#pragma unroll
                for (int n = 0; n < 2; ++n) acc[a][b][m][n] = (f32x4){0.f, 0.f, 0.f, 0.f};
    i32x8 At[4], B0[2], B1[2];
    unsigned vAc[2][2], vAn[2][2];
    { PG8_GEOM(sR, sCb); am.a_offs(cur, sR, sCb, vAc); }
    const char* cA = am.a_base(cur); const char* cB = am.b_base(cur);
    { PG8_VOFFB(vb0_, 0); PG8_STAGE(PG8_SB(0, 0), cB, vb0_); } { PG8_VOFFB(vb1_, 1); PG8_STAGE(PG8_SB(0, 1), cB, vb1_); } PG8_STAGE(PG8_SA(0, 0), cA, vAc[0]); PG8_STAGE(PG8_SA(0, 1), cA, vAc[1]);
    if (wr == 1) PG8_BAR;
    PG8_WAIT_V(2); PG8_BAR;
    { PG8_VOFFB(vb0_, 0); PG8_STAGE(PG8_SB(1, 0), cB + kstep, vb0_); } PG8_STAGE(PG8_SA(1, 0), cA + kstep, vAc[0]); { PG8_VOFFB(vb1_, 1); PG8_STAGE(PG8_SB(1, 1), cB + kstep, vb1_); }
    PG8_WAIT_V(6); PG8_BAR;
    for (;;) {
        const bool has_next = S.next(ui + 1, nxt);
        const char* nA = cA; const char* nB = cB;
#pragma unroll
        for (int h = 0; h < 2; ++h)
#pragma unroll
            for (int i = 0; i < 2; ++i) vAn[h][i] = vAc[h][i];
        if (has_next) { nA = am.a_base(nxt); nB = am.b_base(nxt); PG8_GEOM(sR, sCb); am.a_offs(nxt, sR, sCb, vAn); }
#pragma unroll 1
        for (int t = 0; t < nt; t += 2) {
            const bool last = (t == nt - 2);
            const char* a1 = cA + (size_t)(t + 1) * kstep;
            const char* a2 = last ? nA : cA + (size_t)(t + 2) * kstep; const char* b2 = last ? nB : cB + (size_t)(t + 2) * kstep;
            const char* a3 = a2 + kstep; const char* b3 = b2 + kstep;
            PG8_LDB(B0, 0, 0); PG8_LDB(B1, 0, 1); PG8_SCHED; PG8_LDA(At, 0, 0); PG8_STAGE(PG8_SA(1, 1), a1, vAc[1]);
            if (last) {
#pragma unroll
                for (int h = 0; h < 2; ++h)
#pragma unroll
                    for (int i = 0; i < 2; ++i) vAc[h][i] = vAn[h][i]; }
            PG8_WAIT_V(8); PG8_WAIT_L(0); PG8_BAR; PG8_MMA(0, 0, At, B0); PG8_MMA(0, 1, At, B1); PG8_BAR; PG8_SCHED;
            PG8_LDA(At, 0, 1); { PG8_VOFFB(vb0_, 0); PG8_STAGE(PG8_SB(0, 0), b2, vb0_); } { PG8_VOFFB(vb1_, 1); PG8_STAGE(PG8_SB(0, 1), b2, vb1_); } PG8_STAGE(PG8_SA(0, 0), a2, vAc[0]);
            PG8_WAIT_V(8); PG8_WAIT_L(0); PG8_BAR; PG8_MMA(1, 0, At, B0); PG8_MMA(1, 1, At, B1); PG8_BAR; PG8_SCHED;
            PG8_LDB(B0, 1, 0); PG8_LDB(B1, 1, 1); PG8_SCHED; PG8_LDA(At, 1, 0); PG8_STAGE(PG8_SA(0, 1), a2, vAc[1]);
            PG8_WAIT_V(8); PG8_WAIT_L(0); PG8_BAR; PG8_MMA(0, 0, At, B0); PG8_MMA(0, 1, At, B1); PG8_BAR; PG8_SCHED;
            PG8_LDA(At, 1, 1); { PG8_VOFFB(vb0_, 0); PG8_STAGE(PG8_SB(1, 0), b3, vb0_); } { PG8_VOFFB(vb1_, 1); PG8_STAGE(PG8_SB(1, 1), b3, vb1_); } PG8_STAGE(PG8_SA(1, 0), a3, vAc[0]);
            PG8_WAIT_V(8); PG8_WAIT_L(0); PG8_BAR; PG8_MMA(1, 0, At, B0); PG8_MMA(1, 1, At, B1); PG8_BAR; PG8_SCHED;
        }
        if (wr == 0) PG8_BAR;
        asm volatile("s_nop 15\n\ts_nop 15\n\ts_nop 15" ::: "memory");
        { int l2 = threadIdx.x & 63; asm volatile("" : "+v"(l2)); E(acc, cur, wr, wc, l2 & 15, l2 >> 4); }
        if (!has_next) break;
#pragma unroll
        for (int a = 0; a < 2; ++a)
#pragma unroll
            for (int b = 0; b < 2; ++b)
#pragma unroll
                for (int m = 0; m < 4; ++m)
#pragma unroll
                    for (int n = 0; n < 2; ++n) acc[a][b][m][n] = (f32x4){0.f, 0.f, 0.f, 0.f};
        cur = nxt; cA = nA; cB = nB; ++ui;
        if (wr == 1) PG8_BAR;
    }
    PG8_WAIT_V(0);
    PG8_BAR;
#undef PG8_SA
#undef PG8_SB
#undef PG8_STAGE
#undef PG8_LD2
#undef PG8_LDA
#undef PG8_LDB
#undef PG8_MMA
#undef PG8_WAIT_V
#undef PG8_WAIT_L
#undef PG8_BAR
#undef PG8_GEOM
#undef PG8_VOFFB
#undef PG8_SCHED
}
}

#define XB_TMO      128
#define XB_XCNT(j)  (256  + 64 * (j))
#define XB_XSUB(j)  (1280 + 64 * (j))
#define XB_XGEN(j)  (2304 + 64 * (j))
#define XB_TOP      3328
#define XB_TOPGEN   3392
#define XCD_BAR_WORDS 3456
#define XB_SPIN_CAP (1u << 18)
__device__ __forceinline__ unsigned xb_ld(unsigned* p)              { return __hip_atomic_load(p, __ATOMIC_RELAXED, __HIP_MEMORY_SCOPE_AGENT); }
__device__ __forceinline__ unsigned xb_add(unsigned* p, unsigned v) { return __hip_atomic_fetch_add(p, v, __ATOMIC_RELAXED, __HIP_MEMORY_SCOPE_AGENT); }
__device__ __forceinline__ unsigned xb_xcc_id() { return (unsigned)__builtin_amdgcn_s_getreg((3 << 11) | 20) & 0xFu; }
#define XB_SPIN(cond, bar) do { unsigned _sp = 0; while (cond) { __builtin_amdgcn_s_sleep(1); \
    if ((++_sp & 255u) == 0u) { if (xb_ld(&(bar)[XB_TMO])) break; if (_sp > XB_SPIN_CAP) { atomicAdd(&(bar)[XB_TMO], 1u); break; } } } } while (0)
struct XcdBarrier { unsigned* bar; unsigned x; volatile LAS unsigned* st; };
__device__ __forceinline__ XcdBarrier xcd_barrier_post(unsigned* bar, volatile LAS unsigned* st) {
    XcdBarrier b; b.bar = bar; b.x = xb_xcc_id(); b.st = st;
    if (threadIdx.x == 0) (void)xb_add(&bar[XB_XCNT(b.x)], 1u);
    return b;
}
__device__ __forceinline__ void xcd_barrier_complete(unsigned* bar, unsigned x, unsigned& nloc, unsigned& nx) {
    const unsigned G = gridDim.x * gridDim.y * gridDim.z;
    unsigned sum, cnt, mine, sp = 0u;
    for (;;) {
        sum = 0u; cnt = 0u; mine = 0u;
#pragma unroll
        for (unsigned j = 0; j < 16; ++j) { const unsigned c = xb_ld(&bar[XB_XCNT(j)]); sum += c; cnt += (c > 0u) ? 1u : 0u; mine = (j == x) ? c : mine; }
        if (sum == G) break;
        __builtin_amdgcn_s_sleep(1);
        if ((++sp & 255u) == 0u) { if (xb_ld(&bar[XB_TMO])) break; if (sp > XB_SPIN_CAP) { atomicAdd(&bar[XB_TMO], 1u); break; } }
    }
    nloc = mine > 0u ? mine : 1u; nx = cnt > 0u ? cnt : 1u;
}
__device__ __forceinline__ void xcd_barrier(const XcdBarrier& b) {
    asm volatile("s_waitcnt vmcnt(0)" ::: "memory");
    __syncthreads();
    if (threadIdx.x == 0) {
        unsigned* bar = b.bar;
        __builtin_amdgcn_s_waitcnt(0);
        unsigned nloc = b.st[0], nx = b.st[1];
        if (nloc == 0u) { xcd_barrier_complete(bar, b.x, nloc, nx); b.st[0] = nloc; b.st[1] = nx; }
        const unsigned old = xb_add(&bar[XB_XSUB(b.x)], 1u);
        const unsigned gen = old / nloc;
        if (old + 1u == (gen + 1u) * nloc) {
            __builtin_amdgcn_fence(__ATOMIC_RELEASE, "agent");
            asm volatile("s_waitcnt vmcnt(0)" ::: "memory");
            const unsigned og = xb_add(&bar[XB_TOP], 1u);
            const unsigned tg = og / nx;
            if (og + 1u == (tg + 1u) * nx) xb_add(&bar[XB_TOPGEN], 1u);
            else XB_SPIN(xb_ld(&bar[XB_TOPGEN]) == tg, bar);
            __builtin_amdgcn_fence(__ATOMIC_ACQUIRE, "agent");
            xb_add(&bar[XB_XGEN(b.x)], 1u);
            asm volatile("s_waitcnt vmcnt(0)" ::: "memory");
        } else {
            XB_SPIN(xb_ld(&bar[XB_XGEN(b.x)]) == gen, bar);
            __builtin_amdgcn_fence(__ATOMIC_ACQUIRE, "agent");
            asm volatile("s_waitcnt vmcnt(0)" ::: "memory");
        }
    }
    __syncthreads();
}


namespace attn {
typedef int i32x8 __attribute__((ext_vector_type(8)));
typedef float f32x16 __attribute__((ext_vector_type(16)));
constexpr int SLOT = 16384, NT = (SEQ + CTXL) / 64, NUNITS = NB * 8 * (SEQ / 128), VT_TILE = 8192;
constexpr float THR = 6.0f;
#define AT_SB() __builtin_amdgcn_sched_barrier(0)
__device__ __forceinline__ float max3f(float a, float b, float c) { float r; asm("v_max3_f32 %0, %1, %2, %3" : "=v"(r) : "v"(a), "v"(b), "v"(c)); return r; }
__device__ __forceinline__ float rowmax32(const f32x16& a, const f32x16& b) { float m0 = max3f(a[0], a[1], b[0]), m1 = max3f(a[2], a[3], b[1]); m0 = max3f(m0, b[2], b[3]);
#pragma unroll
    for (int i = 4; i < 16; i += 4) { m0 = max3f(m0, a[i], a[i + 1]); m1 = max3f(m1, a[i + 2], a[i + 3]); m0 = max3f(m0, b[i], b[i + 1]); m1 = max3f(m1, b[i + 2], b[i + 3]); }
    float m; asm("v_max_f32_e32 %0, %1, %2" : "=v"(m) : "v"(m0), "v"(m1)); return m; }
__device__ __forceinline__ int crow(int i, int h) { return (i & 3) + 8 * (i >> 2) + 4 * h; }
__device__ __forceinline__ void vtile(const u16* __restrict__ VBw, unsigned char* __restrict__ VT8, int G, int bx) {
    const unsigned char* VB = (const unsigned char*)VBw;
    int tid = threadIdx.x; asm volatile("" : "+v"(tid));
    const int dq = tid & 31, cc = (tid >> 5) & 3, h = cc >> 1, jh = cc & 1;
    for (int it = bx * 4 + (tid >> 7); it < NB * 8 * NT; it += G * 4) {
        const int bh = it / NT, t = it - bh * NT, b = bh >> 3, hh = bh & 7;
        const size_t rowbase = t < 128 ? (size_t)b * SEQ + 64 * t : (size_t)TL + (size_t)b * CTXL + 64 * (t - 128);
        const unsigned char* src = VB + rowbase * D + hh * 128 + 4 * dq;
        unsigned w[16];
#pragma unroll
        for (int i = 0; i < 16; ++i) w[i] = __builtin_nontemporal_load((const unsigned*)(src + (size_t)(32 * jh + crow(i, h)) * D));
        unsigned o[4][4];
#pragma unroll
        for (int g = 0; g < 4; ++g) { const unsigned w0 = w[4 * g], w1 = w[4 * g + 1], w2 = w[4 * g + 2], w3 = w[4 * g + 3];
            const unsigned l01 = __builtin_amdgcn_perm(w1, w0, 0x05010400u), h01 = __builtin_amdgcn_perm(w1, w0, 0x07030602u), l23 = __builtin_amdgcn_perm(w3, w2, 0x05010400u), h23 = __builtin_amdgcn_perm(w3, w2, 0x07030602u);
            o[0][g] = __builtin_amdgcn_perm(l23, l01, 0x05040100u); o[1][g] = __builtin_amdgcn_perm(l23, l01, 0x07060302u); o[2][g] = __builtin_amdgcn_perm(h23, h01, 0x05040100u); o[3][g] = __builtin_amdgcn_perm(h23, h01, 0x07060302u); }
        unsigned char* dst = VT8 + ((size_t)bh * NT + t) * VT_TILE + (size_t)(4 * dq) * 64 + ((cc ^ (dq & 3)) << 4);
#pragma unroll
        for (int bq = 0; bq < 4; ++bq) *(v4u*)(dst + bq * 64) = (v4u){o[bq][0], o[bq][1], o[bq][2], o[bq][3]};
    }
}
__device__ __forceinline__ void phase(LAS unsigned char* lds, const unsigned char* __restrict__ QK8, const unsigned char* __restrict__ VT8, u16* __restrict__ O, const float* __restrict__ tab, const float* __restrict__ norm_g, int G, int bx) {
    int tid = threadIdx.x; asm volatile("" : "+v"(tid));
    const int wave = __builtin_amdgcn_readfirstlane(tid >> 6), lane = tid & 63, r = lane & 31, h = lane >> 5, mp = wave >> 2, qs = wave & 3;
    const int vcu = (G % 8 == 0) ? (bx % 8) * (G / 8) + bx / 8 : bx;
    const int scale1 = 0x7f7f7f7f;
    const int koff = r * 128 + (((4 * mp + 2 * h) ^ ((r >> 1) & 7)) << 4);
    const int voff = 8192 + r * 64 + (((2 * h) ^ ((r >> 2) & 3)) << 4);
#define AT_LD32(dst, p0) do { const v4u lo_ = *(const LAS v4u*)(p0), hi_ = *(const LAS v4u*)((const LAS unsigned char*)(lds) + ((int)((p0) - (const LAS unsigned char*)(lds)) ^ 16)); \
        dst = (i32x8){(int)lo_.x, (int)lo_.y, (int)lo_.z, (int)lo_.w, (int)hi_.x, (int)hi_.y, (int)hi_.z, (int)hi_.w}; } while (0)
    for (int uu = vcu, it = 0; uu < NUNITS; uu += G, ++it) {
        const int u = (G == 256) ? ((8 * (it >> 1) + (bx & 7)) << 6) + 32 * (it & 1) + (bx >> 3) : uu;
        const int bh = u >> 6, qb = u & 63, b = bh >> 3, hh = bh & 7;
        const size_t qrow = (size_t)b * SEQ + qb * 128 + qs * 32 + r;
        i32x8 qf; { const v4u lo = *(const v4u*)(QK8 + qrow * 2048 + (hh * 2 + mp) * 64 + 32 * h), hi = *(const v4u*)(QK8 + qrow * 2048 + (hh * 2 + mp) * 64 + 32 * h + 16);
            qf = (i32x8){(int)lo.x, (int)lo.y, (int)lo.z, (int)lo.w, (int)hi.x, (int)hi.y, (int)hi.z, (int)hi.w}; }
        const int kkey = 8 * wave + (lane >> 3), kch = (lane & 7) ^ ((kkey >> 1) & 7);
        const char* kbase = (const char*)(QK8 + ((size_t)b * SEQ + kkey) * 2048 + 1024 + hh * 128 + kch * 16);
        const char* vbase = (const char*)(VT8 + (size_t)bh * NT * VT_TILE + wave * 1024 + lane * 16);
        const size_t ctx_shift = ((size_t)TL + (size_t)b * CTXL - ((size_t)b * SEQ + SEQ)) * 2048;
#define AT_DMA(t, slot) do { const size_t off_ = (size_t)(t) * 64 * 2048 + ((t) >= 128 ? ctx_shift : 0); LAS unsigned char* d_ = lds + (slot) * SLOT + wave * 1024; \
        __builtin_amdgcn_global_load_lds((const unsigned*)(kbase + off_), (LAS unsigned*)(d_), 16, 0, 0); \
        __builtin_amdgcn_global_load_lds((const unsigned*)(vbase + (size_t)(t) * VT_TILE), (LAS unsigned*)(d_ + 8192), 16, 0, 0); } while (0)
        AT_DMA(0, 0); AT_DMA(1, 1); AT_DMA(2, 2); AT_DMA(3, 3); AT_DMA(4, 4); AT_DMA(5, 5); AT_DMA(6, 6);
        f32x16 o[4];
#pragma unroll
        for (int d = 0; d < 4; ++d)
#pragma unroll
            for (int i = 0; i < 16; ++i) o[d][i] = 0.f;
        float mref = 0.f, l = 0.f;
        f32x16 negm;
#pragma unroll
        for (int i = 0; i < 16; ++i) negm[i] = 0.f;
        f32x16 sA0, sA1, sB0, sB1;
        i32x8 pwc;
        i32x8 kf0, kf1;
        asm volatile("s_waitcnt vmcnt(10)" ::: "memory"); __builtin_amdgcn_s_barrier();
        AT_LD32(kf0, lds + koff); AT_LD32(kf1, lds + koff + 4096);
        sA0 = __builtin_amdgcn_mfma_scale_f32_32x32x64_f8f6f4(kf0, qf, negm, 0, 0, 0, scale1, 0, scale1);
        sA1 = __builtin_amdgcn_mfma_scale_f32_32x32x64_f8f6f4(kf1, qf, negm, 0, 0, 0, scale1, 0, scale1);
        { asm volatile("s_nop 15\n\ts_nop 7" : "+v"(sA0), "+v"(sA1));     float rm = rowmax32(sA0, sA1);
            { const auto sw_ = __builtin_amdgcn_permlane32_swap(__float_as_uint(rm), __float_as_uint(rm), false, false); rm = fmaxf(__uint_as_float(sw_[0]), __uint_as_float(sw_[1])); } mref = rm;
#pragma unroll
            for (int i = 0; i < 16; ++i) { sA0[i] = __builtin_amdgcn_exp2f(sA0[i] - rm); sA1[i] = __builtin_amdgcn_exp2f(sA1[i] - rm); negm[i] = -rm; l += sA0[i] + sA1[i]; }
#pragma unroll
            for (int q = 0; q < 4; ++q) { pwc[q] = (int)pg8::pk4_fp8(sA0[4 * q], sA0[4 * q + 1], sA0[4 * q + 2], sA0[4 * q + 3]); pwc[4 + q] = (int)pg8::pk4_fp8(sA1[4 * q], sA1[4 * q + 1], sA1[4 * q + 2], sA1[4 * q + 3]); } }
        AT_LD32(kf0, lds + SLOT + koff); AT_LD32(kf1, lds + SLOT + koff + 4096);
        sA0 = __builtin_amdgcn_mfma_scale_f32_32x32x64_f8f6f4(kf0, qf, negm, 0, 0, 0, scale1, 0, scale1);
        sA1 = __builtin_amdgcn_mfma_scale_f32_32x32x64_f8f6f4(kf1, qf, negm, 0, 0, 0, scale1, 0, scale1);
#define AT_PIN16(x) asm volatile("" : "+v"(x))
#define AT_PIN2(a_, b_) asm volatile("" : "+v"(a_), "+v"(b_))
#define AT_GAP(S, base, d) do { AT_PIN16(S); float e_[8]; \
            _Pragma("unroll") for (int k = 0; k < 8; ++k) { e_[k] = __builtin_amdgcn_exp2f(S[(base) + k]); ls += e_[k]; } \
            int w0_ = (int)pg8::pk4_fp8(e_[0], e_[1], e_[2], e_[3]), w1_ = (int)pg8::pk4_fp8(e_[4], e_[5], e_[6], e_[7]); AT_PIN2(w0_, w1_); pwn[2 * (d)] = w0_; pwn[2 * (d) + 1] = w1_; } while (0)
#define AT_PVMFMA(d, V) asm volatile("v_mfma_scale_f32_32x32x64_f8f6f4 %0, %1, %2, %0, %3, %3 op_sel_hi:[0,0,0]" : "+v"(o[d]) : "v"(V), "v"(pwc), "v"(scale1))
#define AT_STEP(C0, C1, N0, N1) do { \
            { const int ahead_ = ((t + 6 < NT - 1) ? t + 6 : NT - 1) - (t + 2); \
              if (ahead_ >= 4) asm volatile("s_waitcnt vmcnt(8)" ::: "memory"); else if (ahead_ == 3) asm volatile("s_waitcnt vmcnt(6)" ::: "memory"); else if (ahead_ == 2) asm volatile("s_waitcnt vmcnt(4)" ::: "memory"); \
              else if (ahead_ == 1) asm volatile("s_waitcnt vmcnt(2)" ::: "memory"); else asm volatile("s_waitcnt vmcnt(0)" ::: "memory"); } \
            __builtin_amdgcn_s_barrier(); \
            if (t + 7 < NT) AT_DMA(t + 7, (t + 7) & 7); \
            const LAS unsigned char* sl = lds + (t & 7) * SLOT; const LAS unsigned char* sn = lds + ((t + 2) & 7) * SLOT; \
            i32x8 va, vb, pwn; float ls = 0.f, fsc = 1.0f; bool resc = false; \
            if (t + 2 < NT) { AT_LD32(kf0, sn + koff); AT_LD32(kf1, sn + koff + 4096); \
                N0 = __builtin_amdgcn_mfma_scale_f32_32x32x64_f8f6f4(kf0, qf, negm, 0, 0, 0, scale1, 0, scale1); \
                N1 = __builtin_amdgcn_mfma_scale_f32_32x32x64_f8f6f4(kf1, qf, negm, 0, 0, 0, scale1, 0, scale1); } \
            AT_LD32(va, sl + voff); AT_LD32(vb, sl + voff + 2048); \
            AT_SB(); \
            { float rm = rowmax32(C0, C1); \
                { const auto sw_ = __builtin_amdgcn_permlane32_swap(__float_as_uint(rm), __float_as_uint(rm), false, false); rm = fmaxf(__uint_as_float(sw_[0]), __uint_as_float(sw_[1])); } \
                if (__any(rm > THR)) { const float dl = fmaxf(rm, 0.f); fsc = __builtin_amdgcn_exp2f(-dl); mref += dl; resc = true; \
                    _Pragma("unroll") for (int i = 0; i < 16; ++i) { C0[i] -= dl; C1[i] -= dl; negm[i] = -mref; } \
                    if (t + 2 < NT) { _Pragma("unroll") for (int i = 0; i < 16; ++i) { N0[i] -= dl; N1[i] -= dl; } } } } \
            AT_SB(); \
            asm volatile("s_nop 1" ::: "memory"); \
            AT_PVMFMA(0, va); AT_LD32(va, sl + voff + 4096); AT_GAP(C0, 0, 0); \
            AT_PVMFMA(1, vb); AT_LD32(vb, sl + voff + 6144); AT_GAP(C0, 8, 1); \
            AT_PVMFMA(2, va); AT_GAP(C1, 0, 2); \
            AT_PVMFMA(3, vb); AT_GAP(C1, 8, 3); \
            if (resc) { asm volatile("s_nop 15\n\ts_nop 15\n\ts_nop 15\n\ts_nop 15\n\ts_nop 15" ::: "memory"); l *= fsc; \
                _Pragma("unroll") for (int d = 0; d < 4; ++d) _Pragma("unroll") for (int i = 0; i < 16; ++i) o[d][i] *= fsc; } \
            l += ls; pwc = pwn; } while (0)
        asm volatile("s_nop 15\n\ts_nop 7" : "+v"(sA0), "+v"(sA1));
        for (int t = 0; t + 1 < NT; t += 2) {
            AT_STEP(sA0, sA1, sB0, sB1);
            ++t; if (t + 1 < NT) AT_STEP(sB0, sB1, sA0, sA1); --t;
        }
#undef AT_STEP
        {
            asm volatile("s_waitcnt vmcnt(0)" ::: "memory"); __builtin_amdgcn_s_barrier();
            const LAS unsigned char* sl = lds + ((NT - 1) & 7) * SLOT; i32x8 vf[4];
#pragma unroll
            for (int d = 0; d < 4; ++d) AT_LD32(vf[d], sl + voff + d * 2048);
            asm volatile("s_nop 1" ::: "memory");
            AT_PVMFMA(0, vf[0]); AT_PVMFMA(1, vf[1]); AT_PVMFMA(2, vf[2]); AT_PVMFMA(3, vf[3]);
        }
#undef AT_PIN16
#undef AT_PIN2
#undef AT_GAP
#undef AT_PVMFMA
#undef AT_DMA
        l += __shfl_xor(l, 32);
        const float inv = 1.0f / l;
        asm volatile("s_nop 15\n\ts_nop 15\n\ts_nop 15\n\ts_nop 15\n\ts_nop 15\n\ts_waitcnt vmcnt(0) lgkmcnt(0)" ::: "memory"); __builtin_amdgcn_s_barrier();
        int l4 = threadIdx.x & 63; asm volatile("" : "+v"(l4));
        LAS float* ex = (LAS float*)lds + (qs * 64) * 64 + l4;
        if (mp == 1) { const float sc1 = inv * tab[TAB_LAM];
#pragma unroll
            for (int d = 0; d < 4; ++d)
#pragma unroll
                for (int i = 0; i < 16; ++i) ex[(d * 16 + i) * 64] = o[d][i] * sc1; }
        asm volatile("s_waitcnt lgkmcnt(0)" ::: "memory"); __builtin_amdgcn_s_barrier();
        if (mp == 0) { float ss = 0.f;
#pragma unroll
            for (int d = 0; d < 4; ++d)
#pragma unroll
                for (int i = 0; i < 16; ++i) { const float v = o[d][i] * inv - ex[(d * 16 + i) * 64]; o[d][i] = v; ss += v * v; }
            ss += __shfl_xor(ss, 32);
            const float rs = rsqrtf(ss * (1.0f / 128.0f) + RMS_EPS) * (1.0f - LAM_INIT);
            int l3 = threadIdx.x & 63; asm volatile("" : "+v"(l3));
            const int h = l3 >> 5;
            unsigned char* orow = (unsigned char*)O + ((size_t)b * SEQ + qb * 128 + qs * 32 + (l3 & 31)) * D + hh * 128 + 16 * h;
#pragma unroll
            for (int d = 0; d < 4; ++d) { unsigned X[4];
#pragma unroll
                for (int g = 0; g < 4; ++g) { const int dv = 32 * d + 8 * g + 4 * h; const f32x4 ng = *(const f32x4*)(norm_g + dv);
                    X[g] = pg8::pk4_fp8(o[d][4 * g] * rs * ng[0], o[d][4 * g + 1] * rs * ng[1], o[d][4 * g + 2] * rs * ng[2], o[d][4 * g + 3] * rs * ng[3]); }
                const auto s02 = __builtin_amdgcn_permlane32_swap(X[0], X[2], false, false); const auto s13 = __builtin_amdgcn_permlane32_swap(X[1], X[3], false, false);
                *(v4u*)(orow + 32 * d) = (v4u){s02[0], s02[1], s13[0], s13[1]}; } }
        asm volatile("s_waitcnt vmcnt(0) lgkmcnt(0)" ::: "memory"); __builtin_amdgcn_s_barrier();
    }
#undef AT_LD32
}
#undef AT_SB
}


namespace gla {
typedef short bf16x8 __attribute__((ext_vector_type(8)));
typedef short s16x4 __attribute__((ext_vector_type(4)));
typedef float f32x16 __attribute__((ext_vector_type(16)));
constexpr int QSTR = 272, KSTR = 144, SEG2_STEP = 98304 - 83968, V2_STEP = 102400 - 53248;
constexpr int QD_OFF = 0, KI_OFF = 17408, KET_OFF = 34816, V_OFF = 53248, AT_OFF = 61440, SBF_OFF = 67584, SEG_OFF = 83968, EBE_OFF = 88064, OT_OFF = 88576;
#define GLA_BAR() do { asm volatile("s_waitcnt lgkmcnt(0)" ::: "memory"); __builtin_amdgcn_s_barrier(); asm volatile("" ::: "memory"); } while (0)
__device__ __forceinline__ s16x4 vtr(const LAS unsigned char* p) { return __builtin_bit_cast(s16x4, __builtin_amdgcn_ds_read_tr16_b64_v4i16((LAS s16x4*)p)); }
__device__ __forceinline__ unsigned cvtpk(float lo, float hi) { unsigned r; asm volatile("v_cvt_pk_bf16_f32 %0, %1, %2" : "=v"(r) : "v"(lo), "v"(hi)); return r; }
__device__ __forceinline__ bf16x8 pack8(const f32x16& x, int s) { v4u w; w.x = cvtpk(x[8 * s], x[8 * s + 1]); w.y = cvtpk(x[8 * s + 2], x[8 * s + 3]); w.z = cvtpk(x[8 * s + 4], x[8 * s + 5]); w.w = cvtpk(x[8 * s + 6], x[8 * s + 7]); return __builtin_bit_cast(bf16x8, w); }
__device__ __forceinline__ void phase(LAS unsigned char* lds, const u16* __restrict__ P, u16* __restrict__ OF, u16* __restrict__ OB, int G, int bx) {
    int tid = threadIdx.x; asm volatile("" : "+v"(tid));
    const int wave = __builtin_amdgcn_readfirstlane(tid >> 6), lane = tid & 63, r = lane & 31, h = lane >> 5, q4 = (lane & 15) >> 2;
    const int trcol = ((lane >> 4) & 1) * 32 + (lane & 3) * 8;
    for (int u = bx; u < 256; u += G) {
        const int vhalf = (u >> 3) & 1, dir = (u >> 4) & 1, hh = u & 7, b = u >> 5;
        u16* O = dir ? OB : OF;
        const int qcol = hh * 128 + 2 * lane, lcol = (3 + dir) * 1024 + hh * 128 + 2 * lane, vcol = 1024 + hh * 128 + vhalf * 64 + 8 * (tid & 7), ocol = hh * 128 + vhalf * 64;
        for (int i = tid; i < 16384 / 16; i += 512) *(LAS v4u*)(lds + SBF_OFF + i * 16) = (v4u){0u, 0u, 0u, 0u};
        f32x16 S0, S1;
#pragma unroll
        for (int i = 0; i < 16; ++i) { S0[i] = 0.f; S1[i] = 0.f; }
        unsigned qraw[2][8], lraw[2][8]; v4u vraw[2];
        const long sg = dir ? -1 : 1;
#define GLA_RB(cc) ((cc) < 4 ? (long)TL + (long)b * CTXL + (dir ? (long)(CTXL - 1) - (long)(cc) * 64 : (long)(cc) * 64) : (long)b * SEQ + (dir ? (long)(SEQ - 1) - (long)((cc) - 4) * 64 : (long)((cc) - 4) * 64))
#define GLA_LOAD(cc, st) do { const long rb_ = GLA_RB(cc); const u16* pw_ = P + (rb_ + sg * (8 * wave)) * HGN; const long rs_ = sg * HGN; \
        _Pragma("unroll") for (int i = 0; i < 8; ++i) { qraw[st][i] = *(const unsigned*)(pw_ + rs_ * i + qcol); lraw[st][i] = *(const unsigned*)(pw_ + rs_ * i + lcol); } \
        vraw[st] = __builtin_nontemporal_load((const v4u*)(P + (rb_ + sg * (long)(tid >> 3)) * HGN + vcol)); } while (0)
#define GLA_PRE(st) do { float c0_ = 0.f, c1_ = 0.f; _Pragma("unroll") for (int i = 0; i < 8; ++i) { c0_ += h2f(lraw[st][i] & 0xffffu); c1_ += h2f(lraw[st][i] >> 16); } \
            *(LAS f32x2*)(lds + SEG_OFF + (st) * SEG2_STEP + (wave * 128 + 2 * lane) * 4) = (f32x2){c0_, c1_}; \
            { const int t = tid >> 3, vc = tid & 7; *(LAS v4u*)(lds + V_OFF + (st) * V2_STEP + ((vc >> 2) * 4 + (t >> 4)) * 1024 + (t & 15) * 64 + (vc & 3) * 16) = vraw[st]; } } while (0)
        GLA_LOAD(0, 0); GLA_LOAD(1, 1);
        GLA_PRE(0); GLA_BAR();
        auto chunk = [&](const int cc, auto SETC) __attribute__((always_inline)) {
            constexpr int st = decltype(SETC)::value;
            float lf0[8], lf1[8];
#pragma unroll
            for (int i = 0; i < 8; ++i) { lf0[i] = h2f(lraw[st][i] & 0xffffu); lf1[i] = h2f(lraw[st][i] >> 16); }
            float off0 = 0.f, off1 = 0.f, tot0 = 0.f, tot1 = 0.f;
#pragma unroll
            for (int s = 0; s < 8; ++s) { const f32x2 v = *(const LAS f32x2*)(lds + SEG_OFF + st * SEG2_STEP + (s * 128 + 2 * lane) * 4); if (s < wave) { off0 += v.x; off1 += v.y; } tot0 += v.x; tot1 += v.y; }
            const float eb0 = __builtin_amdgcn_exp2f(tot0), eb1 = __builtin_amdgcn_exp2f(tot1);
            if (wave == 0) *(LAS f32x2*)(lds + EBE_OFF + 2 * lane * 4) = (f32x2){eb0, eb1};
            unsigned ke0[4], ke1[4];
            float e0 = __builtin_amdgcn_exp2f(off0), e1 = __builtin_amdgcn_exp2f(off1);
#pragma unroll
            for (int i = 0; i < 8; i += 2) { float x0[2], x1[2];
#pragma unroll
                for (int u = 0; u < 2; ++u) { const int ii = i + u;
                    const float f0 = __builtin_amdgcn_exp2f(lf0[ii]), f1 = __builtin_amdgcn_exp2f(lf1[ii]), k0 = 1.0f - f0, k1 = 1.0f - f1;
                    e0 *= f0; e1 *= f1;
                    const float ei0 = __builtin_amdgcn_rcpf(e0), ei1 = __builtin_amdgcn_rcpf(e1);
                    const float q0 = bflo(qraw[st][ii]), q1 = bfhi(qraw[st][ii]);
                    const int t = 8 * wave + ii;
                    *(LAS unsigned*)(lds + QD_OFF + t * QSTR + lane * 4) = cvtpk(q0 * e0, q1 * e1);
                    *(LAS unsigned*)(lds + KI_OFF + t * QSTR + lane * 4) = cvtpk(k0 * ei0, k1 * ei1);
                    x0[u] = k0 * ei0 * eb0; x1[u] = k1 * ei1 * eb1; }
                ke0[i >> 1] = cvtpk(x0[0], x0[1]); ke1[i >> 1] = cvtpk(x1[0], x1[1]); }
            *(LAS v4u*)(lds + KET_OFF + (2 * lane) * KSTR + wave * 16) = (v4u){ke0[0], ke0[1], ke0[2], ke0[3]};
            *(LAS v4u*)(lds + KET_OFF + (2 * lane + 1) * KSTR + wave * 16) = (v4u){ke1[0], ke1[1], ke1[2], ke1[3]};
            if (cc + 2 < 132) GLA_LOAD(cc + 2, st);
            GLA_BAR();
            f32x16 acc;
#pragma unroll
            for (int i = 0; i < 16; ++i) acc[i] = 0.f;
            if (wave < 3) { const int sb = wave >> 1, tb = (wave + 1) >> 1;
#pragma unroll
                for (int ks = 0; ks < 8; ++ks) { const bf16x8 a = *(const LAS bf16x8*)(lds + KI_OFF + (32 * sb + r) * QSTR + (16 * ks + 8 * h) * 2), bq = *(const LAS bf16x8*)(lds + QD_OFF + (32 * tb + r) * QSTR + (16 * ks + 8 * h) * 2);
                    acc = __builtin_amdgcn_mfma_f32_32x32x16_bf16(a, bq, acc, 0, 0, 0); }
                if (sb == tb) {
#pragma unroll
                    for (int i = 0; i < 16; ++i) { const int srow = (i & 3) + 8 * (i >> 2) + 4 * h; if (srow > r) acc[i] = 0.f; } }
                *(LAS bf16x8*)(lds + AT_OFF + (wave * 2 + 0) * 1024 + lane * 16) = pack8(acc, 0);
                *(LAS bf16x8*)(lds + AT_OFF + (wave * 2 + 1) * 1024 + lane * 16) = pack8(acc, 1);
            } else if (wave >= 4) { const int tb = (wave - 4) >> 1, vb = (wave - 4) & 1;
#pragma unroll
                for (int ks = 0; ks < 8; ++ks) { const LAS unsigned char* qp = lds + QD_OFF + (32 * tb + r) * QSTR + (16 * ks + 4 * h) * 2;
                    const v2u lo = *(const LAS v2u*)qp, hi = *(const LAS v2u*)(qp + 16);
                    const bf16x8 a = __builtin_bit_cast(bf16x8, (v4u){lo.x, lo.y, hi.x, hi.y});
                    const bf16x8 bs = *(const LAS bf16x8*)(lds + SBF_OFF + (((ks >> 1) * 2 + vb) * 2 + (ks & 1)) * 1024 + lane * 16);
                    acc = __builtin_amdgcn_mfma_f32_32x32x16_bf16(a, bs, acc, 0, 0, 0); } }
            GLA_BAR();
            if (wave >= 4) { const int tb = (wave - 4) >> 1, vb = (wave - 4) & 1;
#pragma unroll
                for (int sb = 0; sb < 2; ++sb) { if (sb <= tb) {
#pragma unroll
                    for (int sub = 0; sub < 2; ++sub) { const bf16x8 a = *(const LAS bf16x8*)(lds + AT_OFF + ((sb + tb) * 2 + sub) * 1024 + lane * 16);
                        const LAS unsigned char* vp = lds + V_OFF + st * V2_STEP + (vb * 4 + 2 * sb + sub) * 1024 + (4 * h + q4) * 64 + trcol; const s16x4 lo = vtr(vp), hi = vtr(vp + 512);
                        const bf16x8 bv = {lo[0], lo[1], lo[2], lo[3], hi[0], hi[1], hi[2], hi[3]};
                        acc = __builtin_amdgcn_mfma_f32_32x32x16_bf16(a, bv, acc, 0, 0, 0); } } }
                u16* ob_ = O + (GLA_RB(cc) + sg * (long)(32 * tb + 4 * h)) * D + ocol + 32 * vb + r; const long os_ = sg * D;
#pragma unroll
                for (int i = 0; i < 16; ++i) ob_[os_ * ((i & 3) + 8 * (i >> 2))] = (u16)f2bf(acc[i]);
            } else { const int kb = wave;
#pragma unroll
                for (int g = 0; g < 4; ++g) { const f32x4 e = *(const LAS f32x4*)(lds + EBE_OFF + (32 * kb + 8 * g + 4 * h) * 4);
#pragma unroll
                    for (int i = 0; i < 4; ++i) { S0[4 * g + i] *= e[i]; S1[4 * g + i] *= e[i]; } }
#pragma unroll
                for (int s4 = 0; s4 < 4; ++s4) { const bf16x8 a = *(const LAS bf16x8*)(lds + KET_OFF + (32 * kb + r) * KSTR + (16 * s4 + 8 * h) * 2);
                    const LAS unsigned char* vp0 = lds + V_OFF + st * V2_STEP + (0 * 4 + s4) * 1024 + (8 * h + q4) * 64 + trcol; const s16x4 l0 = vtr(vp0), h0 = vtr(vp0 + 256);
                    const LAS unsigned char* vp1 = lds + V_OFF + st * V2_STEP + (1 * 4 + s4) * 1024 + (8 * h + q4) * 64 + trcol; const s16x4 l1 = vtr(vp1), h1 = vtr(vp1 + 256);
                    const bf16x8 bv0 = {l0[0], l0[1], l0[2], l0[3], h0[0], h0[1], h0[2], h0[3]}, bv1 = {l1[0], l1[1], l1[2], l1[3], h1[0], h1[1], h1[2], h1[3]};
                    S0 = __builtin_amdgcn_mfma_f32_32x32x16_bf16(a, bv0, S0, 0, 0, 0); S1 = __builtin_amdgcn_mfma_f32_32x32x16_bf16(a, bv1, S1, 0, 0, 0); }
                *(LAS bf16x8*)(lds + SBF_OFF + ((kb * 2 + 0) * 2 + 0) * 1024 + lane * 16) = pack8(S0, 0);
                *(LAS bf16x8*)(lds + SBF_OFF + ((kb * 2 + 0) * 2 + 1) * 1024 + lane * 16) = pack8(S0, 1);
                *(LAS bf16x8*)(lds + SBF_OFF + ((kb * 2 + 1) * 2 + 0) * 1024 + lane * 16) = pack8(S1, 0);
                *(LAS bf16x8*)(lds + SBF_OFF + ((kb * 2 + 1) * 2 + 1) * 1024 + lane * 16) = pack8(S1, 1);
            }
            if (cc + 1 < 132) GLA_PRE(st ^ 1);
            GLA_BAR();
        };
        for (int cc = 0; cc < 132; cc += 2) { chunk(cc, std::integral_constant<int, 0>{}); chunk(cc + 1, std::integral_constant<int, 1>{}); }
#undef GLA_RB
#undef GLA_LOAD
#undef GLA_PRE
        asm volatile("s_waitcnt vmcnt(0)" ::: "memory");
    }
}
#undef GLA_BAR
}

struct Args {
    const float* in[22];
    float* out; unsigned char* ws;
    int s_lo, s_hi;
};
enum { I_X = 0, I_C, I_CTX, I_CCTX, I_WADA, I_BADA, I_LNG, I_LNB, I_HGWIN, I_HGLB, I_HGNG, I_HGWOUT, I_DAWIN, I_DALAM, I_DANG, I_DAWOUT, I_WR, I_BR, I_WGU, I_BGU, I_WDN, I_BDN };

__device__ __forceinline__ void p0_transpose_item(const float* W, int K, int N, u16* WT, int k0, int n0, int row0, LAS float* scr, int lane) {
#pragma unroll 8
    for (int i = 0; i < 32; ++i) { const int kk = 2 * i + (lane >> 5); scr[kk * 33 + (lane & 31)] = W[(size_t)(k0 + kk) * N + n0 + (lane & 31)]; }
    asm volatile("s_waitcnt lgkmcnt(0)" ::: "memory");
    const int c = lane & 7;
#pragma unroll
    for (int j = 0; j < 4; ++j) { const int n = (lane >> 3) + 8 * j; const LAS float* s = scr + (8 * c) * 33 + n;
        v4u o; o.x = pk2(s[0 * 33], s[1 * 33]); o.y = pk2(s[2 * 33], s[3 * 33]); o.z = pk2(s[4 * 33], s[5 * 33]); o.w = pk2(s[6 * 33], s[7 * 33]);
        *(GAS v4u*)(WT + (size_t)(row0 + n) * K + k0 + 8 * c) = o; }
    asm volatile("s_waitcnt lgkmcnt(0)" ::: "memory");
}


__device__ __forceinline__ void p0_transpose_item_f8(const float* W, int K, int N, unsigned char* WT, int k0, int n0, int row0, float scale, LAS float* scr, int lane) {
#pragma unroll 8
    for (int i = 0; i < 32; ++i) { const int kk = 2 * i + (lane >> 5); scr[kk * 33 + (lane & 31)] = __builtin_nontemporal_load(W + (size_t)(k0 + kk) * N + n0 + (lane & 31)) * scale; }
    asm volatile("s_waitcnt lgkmcnt(0)" ::: "memory");
    const int c = lane & 3;
#pragma unroll
    for (int j = 0; j < 2; ++j) { const int n = (lane >> 2) + 16 * j; const LAS float* sp = scr + (16 * c) * 33 + n;
        v4u o; o.x = pg8::pk4_fp8(sp[0 * 33], sp[1 * 33], sp[2 * 33], sp[3 * 33]); o.y = pg8::pk4_fp8(sp[4 * 33], sp[5 * 33], sp[6 * 33], sp[7 * 33]);
        o.z = pg8::pk4_fp8(sp[8 * 33], sp[9 * 33], sp[10 * 33], sp[11 * 33]); o.w = pg8::pk4_fp8(sp[12 * 33], sp[13 * 33], sp[14 * 33], sp[15 * 33]);
        __builtin_nontemporal_store(o, (GAS v4u*)(WT + (size_t)(row0 + n) * K + k0 + 16 * c)); }
    asm volatile("s_waitcnt lgkmcnt(0)" ::: "memory");
}


__global__ void __launch_bounds__(NWAVES * 64, 2) fwd(Args args) {
    extern __shared__ __attribute__((aligned(16))) unsigned char lds_raw[];
    LAS unsigned char* lds = (LAS unsigned char*)lds_raw;
    volatile LAS unsigned* MISC = (volatile LAS unsigned*)(lds + MISC_OFF);
    LAS int* l_tp = (LAS int*)(lds + MISC_OFF + 32);
    LAS int* l_cnt = (LAS int*)(lds + MISC_OFF + 192);
    const int tid = threadIdx.x, lane = tid & 63, wave = __builtin_amdgcn_readfirstlane(tid >> 6);
    const int G = gridDim.x, bx = blockIdx.x;
    const int gw = bx * NWAVES + wave, NGW = G * NWAVES;
    unsigned char* ws = args.ws;
    unsigned* ctl = (unsigned*)(ws + WS_CTL);
    float* MOD = (float*)(ws + WS_MOD);
    float* TAB = (float*)(ws + WS_TAB);
    v2u* TI = (v2u*)(ws + WS_TI);
    int* LIST = (int*)(ws + WS_LIST);
    u16* WHGIN = (u16*)(ws + WS_WHGIN); u16* WHGOUT = (u16*)(ws + WS_WHGOUT); u16* WDAIN = (u16*)(ws + WS_WDAIN); u16* WDAOUT = (u16*)(ws + WS_WDAOUT);
    u16* WGU = (u16*)(ws + WS_WGU); u16* WDN = (u16*)(ws + WS_WDN);
    u16* PROJ0 = (u16*)(ws + WS_PROJ0); u16* ACT = (u16*)(ws + WS_ACT); unsigned char* QK8 = ws + WS_QK8; u16* VB = (u16*)(ws + WS_VB); unsigned char* VT8 = ws + WS_VT8; u16* OATT = (u16*)(ws + WS_O);
    u16* OF = (u16*)(ws + WS_OF); u16* OB = (u16*)(ws + WS_OB); u16* ARO = (u16*)(ws + WS_ARO); u16* ML = (u16*)(ws + WS_ML); u16* Y = (u16*)(ws + WS_Y);
    u16* XL = (u16*)(ws + WS_XL);
    u16* H = (u16*)args.out;
    const float* x = args.in[I_X]; const float* ctxin = args.in[I_CTX];

    if (tid < 128) ((LAS unsigned*)(lds + MISC_OFF))[tid] = 0u;
    __syncthreads();
    XcdBarrier bar = xcd_barrier_post(ctl + CW_BAR, MISC);
    const int lo = args.s_lo, hi = args.s_hi;
#define IN(k) (lo <= (k) && (k) < hi)
#define FRESH_IDS int tid_ = threadIdx.x; asm volatile("" : "+v"(tid_)); const int tid = tid_, lane = tid_ & 63; (void)tid; (void)lane;
#define SEAM(k) do { if (IN(k) && IN((k) + 1)) xcd_barrier(bar); } while (0)

    if (IN(0)) { FRESH_IDS
        LAS float* silu_t = (LAS float*)(lds + 73728);
        for (int i = tid; i < 9 * 1024; i += NWAVES * 64) { const int r = i >> 10, k = i & 1023; const float v = r < 8 ? args.in[I_C][r * 1024 + k] : args.in[I_CCTX][k]; silu_t[i] = v * sigmoidf_(v); }
        __syncthreads();
        { LAS float* red = (LAS float*)(lds + 110592);
          for (int it = bx; it < 2 * 96; it += G) {
            const int l = it / 96, n = (it % 96) * 64 + lane;
            const float* W = args.in[I_WADA] + (size_t)l * 1024 * 6144 + n;
            float a[9];
#pragma unroll
            for (int r = 0; r < 9; ++r) a[r] = 0.f;
#pragma unroll 8
            for (int k = wave * 128; k < wave * 128 + 128; ++k) { const float w = __builtin_nontemporal_load(W + (size_t)k * 6144);
#pragma unroll
                for (int r = 0; r < 9; ++r) a[r] += silu_t[r * 1024 + k] * w; }
#pragma unroll
            for (int r = 0; r < 9; ++r) red[(wave * 9 + r) * 64 + lane] = a[r];
            __syncthreads();
            for (int o = tid; o < 9 * 64; o += NWAVES * 64) { const int r = o >> 6, ln = o & 63; float sum = args.in[I_BADA][l * 6144 + (it % 96) * 64 + ln];
#pragma unroll
                for (int w = 0; w < 8; ++w) sum += red[(w * 9 + r) * 64 + ln];
                MOD[((size_t)l * 9 + r) * 6144 + (it % 96) * 64 + ln] = sum; }
            __syncthreads();
          } }
        LAS float* scr = (LAS float*)(lds + wave * 9216);
        constexpr int I_A = 16 * 160, I_B = 16 * 32, I_Cc = 16 * 96, I_D = 16 * 32, I_E = 64 * 16 * 64, I_F = 64 * 16 * 32;
        constexpr int NITEMS = I_A + I_B + I_Cc + I_D + I_E + I_F;
#define W0_ITEM(itx) do { int r = (itx); \
            if (r < I_A) { const int kb = r / 160, nb = r % 160; p0_transpose_item_f8(args.in[I_HGWIN], 1024, 5120, (unsigned char*)WHGIN, kb * 64, nb * 32, nb * 32, 32.0f, scr, lane); continue; } r -= I_A; \
            if (r < I_B) { const int kb = r / 32, nb = r % 32; p0_transpose_item_f8(args.in[I_HGWOUT], 1024, 1024, (unsigned char*)WHGOUT, kb * 64, nb * 32, nb * 32, 64.0f, scr, lane); continue; } r -= I_B; \
            if (r < I_Cc) { const int kb = r / 96, nb = r % 96; p0_transpose_item_f8(args.in[I_DAWIN], 1024, 3072, (unsigned char*)WDAIN, kb * 64, nb * 32, nb * 32, 32.0f, scr, lane); continue; } r -= I_Cc; \
            if (r < I_D) { const int kb = r / 32, nb = r % 32; p0_transpose_item_f8(args.in[I_DAWOUT], 1024, 1024, (unsigned char*)WDAOUT, kb * 64, nb * 32, nb * 32, 64.0f, scr, lane); continue; } r -= I_D; \
            if (r < I_E) { const int le = r / 1024, q = r % 1024, kb = q / 64, nb = q % 64; const int n0 = nb * 32; \
                const int j = n0 & 1023, row0 = (j >> 7) * 256 + (n0 >= 1024 ? 128 : 0) + (j & 127); \
                p0_transpose_item_f8(args.in[I_WGU] + (size_t)le * 1024 * 2048, 1024, 2048, (unsigned char*)WGU + (size_t)le * 2048 * 1024, kb * 64, n0, row0, 32.0f, scr, lane); continue; } r -= I_E; \
            { const int le = r / 512, q = r % 512, kb = q / 32, nb = q % 32; \
                p0_transpose_item_f8(args.in[I_WDN] + (size_t)le * 1024 * 1024, 1024, 1024, (unsigned char*)WDN + (size_t)le * 1024 * 1024, kb * 64, nb * 32, nb * 32, 64.0f, scr, lane); } } while (0)
        { const bool split = (G == 256);
          for (int it = gw; it < (split ? I_A : NITEMS); it += NGW) W0_ITEM(it); }
        if (bx == 0) {
            for (int i = tid; i < 2048; i += NWAVES * 64) { const int pos = i >> 4, j = i & 15; const float inv = powf(10000.0f, -(float)j / 16.0f); const float ang = (float)pos * inv; TAB[TAB_COS + i] = cosf(ang); TAB[TAB_SIN + i] = sinf(ang); }
            for (int i = tid; i < 2048; i += NWAVES * 64) { const int d = i >> 10, j = i & 1023; const float* t = args.in[I_HGLB] + (size_t)d * 3 * 1024 + j;
                const float t0 = t[0], t1 = t[1024], t2 = t[2048], m = fmaxf(t0, fmaxf(t1, t2)); const float e0 = expf(t0 - m), e1 = expf(t1 - m), e2 = expf(t2 - m); TAB[TAB_LB + i] = e0 / (e0 + e1 + e2); }
            if (tid == 0) { const float* lp = args.in[I_DALAM]; float s01 = 0.f, s23 = 0.f; for (int j = 0; j < 64; ++j) { s01 += lp[j] * lp[64 + j]; s23 += lp[128 + j] * lp[192 + j]; }
                TAB[TAB_LAM] = expf(s01) - expf(s23) + LAM_INIT; }
        }
    }
    SEAM(0);
    if (IN(1)) { FRESH_IDS
        for (int r0 = gw; r0 < TT; r0 += 4 * NGW) {
            f32x4 v[4][4];
#pragma unroll
            for (int q = 0; q < 4; ++q) { const int r = r0 + q * NGW; if (r < TT) { const float* xr = r < TL ? x + (size_t)r * D : ctxin + (size_t)(r - TL) * D;
#pragma unroll
                for (int j = 0; j < 4; ++j) v[q][j] = __builtin_nontemporal_load((const f32x4*)(xr + 4 * lane + 256 * j)); } }
#pragma unroll
            for (int q = 0; q < 4; ++q) { const int r = r0 + q * NGW; if (r < TT) { const int bb = r < TL ? (r >> 13) : 8; const float* md = MOD + (size_t)bb * 6144;
#pragma unroll
                for (int j = 0; j < 4; ++j) { const int c = 4 * lane + 256 * j; const f32x4 sh = *(const f32x4*)(md + c), sc = *(const f32x4*)(md + 1024 + c);
                    const f32x4 hv = v[q][j] * (sc + 1.0f) + sh; *(unsigned*)((unsigned char*)H + (size_t)r * D + c) = pg8::pk4_fp8(hv[0], hv[1], hv[2], hv[3]); } } }
        }
    }
    SEAM(1);
    if (IN(2)) {
        const int jb = bx >> 3;
        if (G == 256 && (jb & 3) == 3) { FRESH_IDS
            LAS float* scr = (LAS float*)(lds + wave * 9216);
            constexpr int I_A = 16 * 160, I_B = 16 * 32, I_Cc = 16 * 96, I_D = 16 * 32, I_E = 64 * 16 * 64, I_F = 64 * 16 * 32;
            constexpr int NITEMS = I_A + I_B + I_Cc + I_D + I_E + I_F;
            const int cw = (((jb >> 2) * 8 + (bx & 7)) * NWAVES) + wave;
            const float* isrc = nullptr; unsigned char* idst = nullptr; int iN = 0; float iscale = 0.f;
#define W0_DECODE(itx) do { int r = (itx) - I_A; \
                if (r < I_B) { const int kb = r / 32, nb = r % 32; iN = 1024; isrc = args.in[I_HGWOUT] + (size_t)(kb * 64) * 1024 + nb * 32; idst = (unsigned char*)WHGOUT + (size_t)(nb * 32) * 1024 + kb * 64; iscale = 64.0f; break; } r -= I_B; \
                if (r < I_Cc) { const int kb = r / 96, nb = r % 96; iN = 3072; isrc = args.in[I_DAWIN] + (size_t)(kb * 64) * 3072 + nb * 32; idst = (unsigned char*)WDAIN + (size_t)(nb * 32) * 1024 + kb * 64; iscale = 32.0f; break; } r -= I_Cc; \
                if (r < I_D) { const int kb = r / 32, nb = r % 32; iN = 1024; isrc = args.in[I_DAWOUT] + (size_t)(kb * 64) * 1024 + nb * 32; idst = (unsigned char*)WDAOUT + (size_t)(nb * 32) * 1024 + kb * 64; iscale = 64.0f; break; } r -= I_D; \
                if (r < I_E) { const int le = r / 1024, q = r % 1024, kb = q / 64, nb = q % 64; const int n0 = nb * 32; \
                    const int j = n0 & 1023, row0 = (j >> 7) * 256 + (n0 >= 1024 ? 128 : 0) + (j & 127); \
                    iN = 2048; isrc = args.in[I_WGU] + (size_t)le * 1024 * 2048 + (size_t)(kb * 64) * 2048 + n0; idst = (unsigned char*)WGU + (size_t)le * 2048 * 1024 + (size_t)row0 * 1024 + kb * 64; iscale = 32.0f; break; } r -= I_E; \
                { const int le = r / 512, q = r % 512, kb = q / 32, nb = q % 32; \
                    iN = 1024; isrc = args.in[I_WDN] + (size_t)le * 1024 * 1024 + (size_t)(kb * 64) * 1024 + nb * 32; idst = (unsigned char*)WDN + (size_t)le * 1024 * 1024 + (size_t)(nb * 32) * 1024 + kb * 64; iscale = 64.0f; } } while (0)
#define W0_LOAD() do { const float* sp_ = isrc + (size_t)(lane >> 5) * iN + (lane & 31); _Pragma("unroll") for (int i = 0; i < 32; ++i) wreg[i] = __builtin_nontemporal_load(sp_ + (size_t)(2 * i) * iN); } while (0)
            float wreg[32];
            int it = I_A + cw;
            if (it < NITEMS) { W0_DECODE(it); W0_LOAD(); }
            for (; it < NITEMS; it += 64 * NWAVES) {
                unsigned char* cdst = idst; const float cscale = iscale;
#pragma unroll
                for (int i = 0; i < 32; ++i) scr[(2 * i + (lane >> 5)) * 33 + (lane & 31)] = wreg[i] * cscale;
                if (it + 64 * NWAVES < NITEMS) { W0_DECODE(it + 64 * NWAVES); W0_LOAD(); }
                asm volatile("s_waitcnt lgkmcnt(0)" ::: "memory");
                const int c = lane & 3;
#pragma unroll
                for (int j = 0; j < 2; ++j) { const int n = (lane >> 2) + 16 * j; const LAS float* sp = scr + (16 * c) * 33 + n;
                    v4u o; o.x = pg8::pk4_fp8(sp[0 * 33], sp[1 * 33], sp[2 * 33], sp[3 * 33]); o.y = pg8::pk4_fp8(sp[4 * 33], sp[5 * 33], sp[6 * 33], sp[7 * 33]);
                    o.z = pg8::pk4_fp8(sp[8 * 33], sp[9 * 33], sp[10 * 33], sp[11 * 33]); o.w = pg8::pk4_fp8(sp[12 * 33], sp[13 * 33], sp[14 * 33], sp[15 * 33]);
                    __builtin_nontemporal_store(o, (GAS v4u*)(cdst + (size_t)n * 1024 + 16 * c)); }
                asm volatile("s_waitcnt lgkmcnt(0)" ::: "memory");
            }
#undef W0_DECODE
#undef W0_LOAD
        } else {
            const int Gg = (G == 256) ? 192 : G, cg = (G == 256) ? (jb - (jb >> 2)) * 8 + (bx & 7) : bx;
            pg8::StaticOrder S; S.init(TT, HGN, Gg, cg); pg8::DenseAB8 am{(const unsigned char*)H, (const unsigned char*)WHGIN}; pg8::EpiHgProj E{PROJ0, TAB + TAB_LB, 1.0f / 32.0f};
            pg8::gemm_phase_f8<pg8::EpiHgProj, pg8::StaticOrder, pg8::DenseAB8>(lds, S, E, am);
        }
    }
#undef W0_ITEM
    SEAM(2);
    if (IN(3)) gla::phase(lds, PROJ0, OF, OB, G, bx);
    SEAM(3);
    if (IN(4)) { FRESH_IDS
        const float* ng = args.in[I_HGNG];
        const int rpw = TT / NGW, rbeg = gw * rpw, rend = rbeg + rpw;
        f32x4 n4v[4]; v2u an[4], bn[4], gn[4];
#pragma unroll
        for (int j = 0; j < 4; ++j) n4v[j] = *(const f32x4*)(ng + 4 * lane + 256 * j);
#define S4_ISSUE(rr) do { const size_t r_ = (size_t)(rr); _Pragma("unroll") for (int j = 0; j < 4; ++j) { const int c = 4 * lane + 256 * j; \
            an[j] = __builtin_nontemporal_load((const v2u*)(OF + r_ * D + c)); bn[j] = __builtin_nontemporal_load((const v2u*)(OB + r_ * D + c)); gn[j] = __builtin_nontemporal_load((const v2u*)(PROJ0 + r_ * HGN + 2048 + c)); } } while (0)
        S4_ISSUE(rbeg);
        for (int r = rbeg; r < rend; ++r) {
            v2u ac[4], bc[4], gc[4];
#pragma unroll
            for (int j = 0; j < 4; ++j) { ac[j] = an[j]; bc[j] = bn[j]; gc[j] = gn[j]; }
            if (r + 1 < rend) S4_ISSUE(r + 1);
            f32x4 o[4]; float ss[4];
#pragma unroll
            for (int j = 0; j < 4; ++j) { const v2u a = ac[j], b2 = bc[j];
                o[j] = (f32x4){bflo(a.x) + bflo(b2.x), bfhi(a.x) + bfhi(b2.x), bflo(a.y) + bflo(b2.y), bfhi(a.y) + bfhi(b2.y)};
                ss[j] = o[j][0] * o[j][0] + o[j][1] * o[j][1] + o[j][2] * o[j][2] + o[j][3] * o[j][3]; }
#pragma unroll
            for (int sft = 1; sft < 16; sft <<= 1) {
#pragma unroll
                for (int j = 0; j < 4; ++j) ss[j] += __shfl_xor(ss[j], sft); }
#pragma unroll
            for (int j = 0; j < 4; ++j) { const auto s16 = __builtin_amdgcn_permlane16_swap(__float_as_uint(ss[j]), __float_as_uint(ss[j]), false, false); ss[j] = __uint_as_float(s16[0]) + __uint_as_float(s16[1]); }
#pragma unroll
            for (int j = 0; j < 4; ++j) { const int c = 4 * lane + 256 * j;
                const float rs = rsqrtf(ss[j] * (1.0f / 128.0f) + RMS_EPS);
                const v2u gg = gc[j]; const f32x4 g4 = {bflo(gg.x), bfhi(gg.x), bflo(gg.y), bfhi(gg.y)};
                f32x4 res;
#pragma unroll
                for (int i = 0; i < 4; ++i) res[i] = o[j][i] * rs * n4v[j][i] * (g4[i] * sigmoidf_(g4[i]));
                *(unsigned*)((unsigned char*)ARO + (size_t)r * D + c) = pg8::pk4_fp8(res[0], res[1], res[2], res[3]); }
        }
#undef S4_ISSUE
    }
    SEAM(4);
    auto layer_body = [&](auto LC) __attribute__((always_inline)) {
        constexpr int l = decltype(LC)::value;
        const int sb = l ? 12 : 5;
        const int nrows = l ? TL : TT;
        if (l == 1) {
            if (IN(10)) {
                pg8::StaticOrder S; S.init(TT, DAN, G, bx); pg8::DenseAB8 am{(const unsigned char*)H, (const unsigned char*)WDAIN}; pg8::EpiDaProj E{QK8, VB, TAB, 1.0f / 32.0f};
                pg8::gemm_phase_f8<pg8::EpiDaProj, pg8::StaticOrder, pg8::DenseAB8>(lds, S, E, am);
            }
            SEAM(10);
            if (IN(11)) { attn::vtile(VB, VT8, G, bx); xcd_barrier(bar);
                attn::phase(lds, QK8, VT8, OATT, TAB, args.in[I_DANG], G, bx); }
            SEAM(11);
        }
        if (IN(sb)) {
            pg8::StaticOrder S; S.init(nrows, D, G, bx); pg8::DenseAB8 am{(const unsigned char*)(l ? OATT : ARO), (const unsigned char*)(l ? WDAOUT : WHGOUT)}; pg8::EpiBf16 E{ML, D, nullptr, 0, 1.0f / 64.0f};
            pg8::gemm_phase_f8<pg8::EpiBf16, pg8::StaticOrder, pg8::DenseAB8>(lds, S, E, am);
        }
        SEAM(sb);
        if (IN(sb + 1)) { FRESH_IDS
            const float* lng = args.in[I_LNG] + (size_t)(l * 2 + 0) * D; const float* lnb = args.in[I_LNB] + (size_t)(l * 2 + 0) * D;
            const float* wr_ = args.in[I_WR] + (size_t)l * D * NE; const float* br_ = args.in[I_BR] + l * NE;
            unsigned* cnt = ctl + CW_CNT + l * 32;
            constexpr int HSTR = 2064, HLO_OFF = 16 * HSTR, PART_OFF = 2 * HLO_OFF;
            LAS unsigned* lcount = (LAS unsigned*)(lds + MISC_OFF + 384);
            LAS unsigned* lbase = lcount + 32;
            LAS unsigned* lslot = (LAS unsigned*)(lds + MISC_OFF + 1024);
            LAS float* part = (LAS float*)(lds + PART_OFF);
            unsigned* TIu = (unsigned*)TI;
            if (tid < 32) lcount[tid] = 0u;
            const int fr = lane & 15, kq = lane >> 4;
            pg8::bf16x8 bh[4][2], bl[4][2];
#pragma unroll
            for (int ks = 0; ks < 4; ++ks)
#pragma unroll
                for (int eb = 0; eb < 2; ++eb) { unsigned hw[4], lw[4];
#pragma unroll
                    for (int i2 = 0; i2 < 4; ++i2) { const int c = 128 * wave + 32 * ks + 8 * kq + 2 * i2; const float w0 = wr_[(size_t)c * NE + 16 * eb + fr], w1 = wr_[(size_t)(c + 1) * NE + 16 * eb + fr];
                        const unsigned hp = pg8::cvt_pk_bf16(w0, w1); hw[i2] = hp; lw[i2] = pg8::cvt_pk_bf16(w0 - bflo(hp), w1 - bfhi(hp)); }
                    bh[ks][eb] = __builtin_bit_cast(pg8::bf16x8, (v4u){hw[0], hw[1], hw[2], hw[3]}); bl[ks][eb] = __builtin_bit_cast(pg8::bf16x8, (v4u){lw[0], lw[1], lw[2], lw[3]}); }
            __syncthreads();
            const int rpb = nrows / G, rbase = bx * rpb, ngr = (rpb + 15) >> 4;
            f32x4 lngv[4], lnbv[4], g1v[4], shv[4], scv[4]; int cur_bb = -1;
#pragma unroll
            for (int j = 0; j < 4; ++j) { const int c = 4 * lane + 256 * j; lngv[j] = *(const f32x4*)(lng + c); lnbv[j] = *(const f32x4*)(lnb + c); }
            f32x4 xn[4]; v2u mn[4];
#define RT_ISSUE(rr) do { const int r_ = (rr); _Pragma("unroll") for (int j = 0; j < 4; ++j) { const int c = 4 * lane + 256 * j; \
                    if (l == 0) { const float* xr_ = (r_ < TL ? x + (size_t)r_ * D : ctxin + (size_t)(r_ - TL) * D); xn[j] = __builtin_nontemporal_load((const f32x4*)(xr_ + c)); } \
                    else { const v2u xx_ = __builtin_nontemporal_load((const v2u*)(XL + (size_t)r_ * D + c)); xn[j] = (f32x4){__uint_as_float(xx_.x), __uint_as_float(xx_.y), 0.f, 0.f}; } \
                    mn[j] = __builtin_nontemporal_load((const v2u*)(ML + (size_t)r_ * D + c)); } } while (0)
            if (2 * wave < rpb) RT_ISSUE(rbase + 2 * wave);
            for (int g = 0; g < ngr; ++g) {
#pragma unroll
                for (int q = 0; q < 2; ++q) { const int lr = 16 * g + 2 * wave + q;
                    if (lr < rpb) { const int r = rbase + lr;
                        const int bb = r < TL ? (r >> 13) : 8;
                        if (bb != cur_bb) { cur_bb = bb; const float* md = MOD + ((size_t)l * 9 + bb) * 6144;
#pragma unroll
                            for (int j = 0; j < 4; ++j) { const int c = 4 * lane + 256 * j; g1v[j] = *(const f32x4*)(md + 2048 + c); shv[j] = *(const f32x4*)(md + 3072 + c); scv[j] = *(const f32x4*)(md + 4096 + c); } }
                        f32x4 v[4]; float s = 0.f;
#pragma unroll
                        for (int j = 0; j < 4; ++j) { f32x4 xv; if (l == 0) xv = xn[j]; else { const unsigned x0 = __float_as_uint(xn[j][0]), x1 = __float_as_uint(xn[j][1]); xv = (f32x4){bflo(x0), bfhi(x0), bflo(x1), bfhi(x1)}; }
                            const v2u mm = mn[j];
                            const f32x4 m4 = {bflo(mm.x), bfhi(mm.x), bflo(mm.y), bfhi(mm.y)}; v[j] = xv * DN_ALPHA + g1v[j] * m4; s += (v[j][0] + v[j][1]) + (v[j][2] + v[j][3]); }
                        { const int ln = q == 0 ? lr + 1 : lr + 15; if (ln < rpb) RT_ISSUE(rbase + ln); }
                        const float mean = wave_sum(s) * (1.0f / D); float s2 = 0.f;
#pragma unroll
                        for (int j = 0; j < 4; ++j) { v[j] = v[j] - mean; s2 += (v[j][0] * v[j][0] + v[j][1] * v[j][1]) + (v[j][2] * v[j][2] + v[j][3] * v[j][3]); }
                        const float rstd = rsqrtf(wave_sum(s2) * (1.0f / D) + LN_EPS);
#pragma unroll
                        for (int j = 0; j < 4; ++j) { const int c = 4 * lane + 256 * j;
                            const f32x4 y = v[j] * rstd * lngv[j] + lnbv[j]; { v2u xo; xo.x = pk2(y[0], y[1]); xo.y = pk2(y[2], y[3]); __builtin_nontemporal_store(xo, (v2u*)(XL + (size_t)r * D + c)); }
                            const f32x4 hv = y * (scv[j] + 1.0f) + shv[j]; *(unsigned*)((unsigned char*)H + (size_t)r * D + c) = pg8::pk4_fp8(hv[0], hv[1], hv[2], hv[3]);
                            const unsigned h0 = pg8::cvt_pk_bf16(hv[0], hv[1]), h1 = pg8::cvt_pk_bf16(hv[2], hv[3]);
                            const unsigned l0 = pg8::cvt_pk_bf16(hv[0] - bflo(h0), hv[1] - bfhi(h0)), l1 = pg8::cvt_pk_bf16(hv[2] - bflo(h1), hv[3] - bfhi(h1));
                            *(LAS v2u*)(lds + (2 * wave + q) * HSTR + c * 2) = (v2u){h0, h1}; *(LAS v2u*)(lds + HLO_OFF + (2 * wave + q) * HSTR + c * 2) = (v2u){l0, l1}; } } }
                __syncthreads();
                {
                    pg8::f32x4 acc0 = {0.f, 0.f, 0.f, 0.f}, acc1 = {0.f, 0.f, 0.f, 0.f};
#pragma unroll
                    for (int ks = 0; ks < 4; ++ks) { const LAS unsigned char* ap = lds + fr * HSTR + (128 * wave + 32 * ks + 8 * kq) * 2;
                        const pg8::bf16x8 ah = *(const LAS pg8::bf16x8*)ap, al = *(const LAS pg8::bf16x8*)(ap + HLO_OFF);
                        acc0 = __builtin_amdgcn_mfma_f32_16x16x32_bf16(ah, bh[ks][0], acc0, 0, 0, 0); acc1 = __builtin_amdgcn_mfma_f32_16x16x32_bf16(ah, bh[ks][1], acc1, 0, 0, 0);
                        acc0 = __builtin_amdgcn_mfma_f32_16x16x32_bf16(al, bh[ks][0], acc0, 0, 0, 0); acc1 = __builtin_amdgcn_mfma_f32_16x16x32_bf16(al, bh[ks][1], acc1, 0, 0, 0);
                        acc0 = __builtin_amdgcn_mfma_f32_16x16x32_bf16(ah, bl[ks][0], acc0, 0, 0, 0); acc1 = __builtin_amdgcn_mfma_f32_16x16x32_bf16(ah, bl[ks][1], acc1, 0, 0, 0); }
#pragma unroll
                    for (int i2 = 0; i2 < 4; ++i2) { part[(wave * 16 + 4 * kq + i2) * 32 + fr] = acc0[i2]; part[(wave * 16 + 4 * kq + i2) * 32 + 16 + fr] = acc1[i2]; } }
                __syncthreads();
#pragma unroll
                for (int q = 0; q < 2; ++q) { const int lr = 16 * g + 2 * wave + q;
                    if (lr < rpb) { const int r = rbase + lr, itr = 2 * g + q;
                        const int me = lane >> 1; float lg = br_[me];
#pragma unroll
                        for (int w2 = 0; w2 < 8; ++w2) lg += part[(w2 * 16 + 2 * wave + q) * 32 + me];
                        float tv[4]; int te[4];
                        unsigned key; { const unsigned ub = __float_as_uint(lg); key = (((ub & 0x80000000u) ? ~ub : (ub | 0x80000000u)) & ~31u) | (unsigned)(31 - me); }
                        int rank = 0;
#pragma unroll
                        for (int j2 = 0; j2 < 32; ++j2) { const unsigned kj = (unsigned)__builtin_amdgcn_readlane((int)key, 2 * j2); rank += (kj > key) ? 1 : 0; }
#pragma unroll
                        for (int k = 0; k < 4; ++k) { const unsigned long long hit = __ballot(rank == k); const int src = __builtin_amdgcn_readfirstlane((int)__builtin_ctzll(hit));
                            te[k] = src >> 1; tv[k] = __uint_as_float((unsigned)__builtin_amdgcn_readlane((int)__float_as_uint(lg), src)); }
                        const float e1 = __expf(tv[1] - tv[0]), e2 = __expf(tv[2] - tv[0]), e3 = __expf(tv[3] - tv[0]); const float inv = 1.0f / (1.0f + e1 + e2 + e3);
                        if (lane < 4) { const int e = lane == 0 ? te[0] : lane == 1 ? te[1] : lane == 2 ? te[2] : te[3]; const float gt = (lane == 0 ? 1.0f : lane == 1 ? e1 : lane == 2 ? e2 : e3) * inv;
                            const unsigned lr2 = __hip_atomic_fetch_add(lcount + e, 1u, __ATOMIC_RELAXED, __HIP_MEMORY_SCOPE_WORKGROUP);
                            lslot[(itr * NWAVES + wave) * 4 + lane] = (unsigned)e | (lr2 << 8); TIu[((size_t)r * 4 + lane) * 2 + 1] = __float_as_uint(gt); } } }
            }
#undef RT_ISSUE
            __syncthreads();
            if (tid < 32) lbase[tid] = __hip_atomic_fetch_add(cnt + tid, lcount[tid], __ATOMIC_RELAXED, __HIP_MEMORY_SCOPE_AGENT);
            __syncthreads();
            for (int itr = 0; itr < 2 * ngr; ++itr) { const int lr = 16 * (itr >> 1) + 2 * wave + (itr & 1), r = rbase + lr;
                if (lr < rpb && lane < 4) { const unsigned pk = lslot[(itr * NWAVES + wave) * 4 + lane]; const int e = pk & 255; const unsigned rank = lbase[e] + (pk >> 8);
                    LIST[(size_t)e * CAP + rank] = r; TIu[((size_t)r * 4 + lane) * 2] = (unsigned)e | (rank << 8); }
            }
        }
        SEAM(sb + 1);
        if (IN(sb + 2) || IN(sb + 3) || IN(sb + 4)) {
            __syncthreads();
            if (tid == 0) { const unsigned* cnt = ctl + CW_CNT + l * 32; int acc = 0;
                for (int e = 0; e < 32; ++e) { const int c = (int)__hip_atomic_load(cnt + e, __ATOMIC_RELAXED, __HIP_MEMORY_SCOPE_AGENT); l_cnt[e] = c; l_tp[e] = acc; acc += (c + 255) >> 8; }
                l_tp[32] = acc; }
            __syncthreads();
        }
        if (IN(sb + 2)) {
            pg8::MoeOrder S{l_tp, 8, G, bx, 0}; pg8::MoeGuAB8 am{(const unsigned char*)H, (const unsigned char*)WGU + (size_t)l * 32 * 2048 * 1024, LIST, l_tp, l_cnt}; pg8::EpiGU8 E{(unsigned char*)ACT, args.in[I_BGU] + (size_t)l * 32 * 2048};
            pg8::gemm_phase_f8<pg8::EpiGU8, pg8::MoeOrder, pg8::MoeGuAB8>(lds, S, E, am);
        }
        SEAM(sb + 2);
        if (IN(sb + 3)) {
            pg8::MoeOrder S{l_tp, 4, G, bx, 1}; pg8::MoeDnAB8 am{(const unsigned char*)ACT, (const unsigned char*)WDN + (size_t)l * 32 * 1024 * 1024}; pg8::EpiDn8 E{Y, args.in[I_BDN] + (size_t)l * 32 * 1024};
            pg8::gemm_phase_f8<pg8::EpiDn8, pg8::MoeOrder, pg8::MoeDnAB8>(lds, S, E, am);
        }
        SEAM(sb + 3);
        if (IN(sb + 4)) { FRESH_IDS
            const float* lng = args.in[I_LNG] + (size_t)(l * 2 + 1) * D; const float* lnb = args.in[I_LNB] + (size_t)(l * 2 + 1) * D;
            const int rpw = nrows / NGW, rbeg = gw * rpw, rend = rbeg + rpw, h0 = (rpw + 1) >> 1;
            f32x4 lngv[4], lnbv[4], g2v[4], shv[4], scv[4]; int cur_bb = -1;
#pragma unroll
            for (int j = 0; j < 4; ++j) { const int c = 4 * lane + 256 * j; lngv[j] = *(const f32x4*)(lng + c); lnbv[j] = *(const f32x4*)(lnb + c); shv[j] = (f32x4){0.f, 0.f, 0.f, 0.f}; scv[j] = shv[j]; }
            v2u tin[2][4]; int yn[2][4][4]; v2u xn[2][4]; float gtn[2][4];
#define CB_TI(q, rr) do { _Pragma("unroll") for (int k = 0; k < 4; ++k) tin[q][k] = TI[(size_t)(rr) * 4 + k]; } while (0)
#define CB_DATA(q, rr) do { const int r_ = (rr); _Pragma("unroll") for (int k = 0; k < 4; ++k) { const unsigned t0_ = tin[q][k].x, t1_ = tin[q][k].y; const int e_ = t0_ & 255, rank_ = t0_ >> 8; \
                    const unsigned char* yr_ = (const unsigned char*)Y + ((size_t)l_tp[e_] * 256 + rank_) * D; gtn[q][k] = __uint_as_float(t1_); \
                    _Pragma("unroll") for (int j = 0; j < 4; ++j) yn[q][k][j] = __builtin_nontemporal_load((const int*)(yr_ + 4 * lane + 256 * j)); } \
                _Pragma("unroll") for (int j = 0; j < 4; ++j) xn[q][j] = __builtin_nontemporal_load((const v2u*)(XL + (size_t)r_ * D + 4 * lane + 256 * j)); } while (0)
#pragma unroll
            for (int q = 0; q < 2; ++q) { const int r0 = rbeg + q * h0, re = q ? rend : rbeg + h0; if (r0 < re) { CB_TI(q, r0); CB_DATA(q, r0); if (r0 + 1 < re) CB_TI(q, r0 + 1); } }
            for (int it = 0; it < h0; ++it) {
#pragma unroll
              for (int q = 0; q < 2; ++q) {
                const int r = rbeg + q * h0 + it, re = q ? rend : rbeg + h0;
                if (r < re) {
                const int bb = r < TL ? (r >> 13) : 8;
                if (bb != cur_bb) { cur_bb = bb; const float* md = MOD + ((size_t)l * 9 + bb) * 6144; const float* md1 = MOD + ((size_t)9 + bb) * 6144;
#pragma unroll
                    for (int j = 0; j < 4; ++j) { const int c = 4 * lane + 256 * j; g2v[j] = *(const f32x4*)(md + 5120 + c); if (l == 0) { shv[j] = *(const f32x4*)(md1 + c); scv[j] = *(const f32x4*)(md1 + 1024 + c); } } }
                int yc[4][4]; v2u xc[4]; float gt[4];
#pragma unroll
                for (int k = 0; k < 4; ++k) { gt[k] = gtn[q][k];
#pragma unroll
                    for (int j = 0; j < 4; ++j) yc[k][j] = yn[q][k][j]; }
#pragma unroll
                for (int j = 0; j < 4; ++j) xc[j] = xn[q][j];
                if (r + 1 < re) { CB_DATA(q, r + 1); if (r + 2 < re) CB_TI(q, r + 2); }
                f32x4 v[4]; float s = 0.f;
#pragma unroll
                for (int j = 0; j < 4; ++j) { const v2u xx = xc[j]; const f32x4 xv = {bflo(xx.x), bfhi(xx.x), bflo(xx.y), bfhi(xx.y)};
                    f32x4 f = {0.f, 0.f, 0.f, 0.f};
#pragma unroll
                    for (int k = 0; k < 4; ++k) { const int yy = yc[k][j]; const f32x2 lo = __builtin_amdgcn_cvt_pk_f32_fp8(yy, false), hi = __builtin_amdgcn_cvt_pk_f32_fp8(yy, true); const f32x4 y4 = {lo[0], lo[1], hi[0], hi[1]}; f += y4 * gt[k]; }
                    v[j] = xv * DN_ALPHA + g2v[j] * f; s += (v[j][0] + v[j][1]) + (v[j][2] + v[j][3]); }
                const float mean = wave_sum(s) * (1.0f / D); float s2 = 0.f;
#pragma unroll
                for (int j = 0; j < 4; ++j) { v[j] = v[j] - mean; s2 += (v[j][0] * v[j][0] + v[j][1] * v[j][1]) + (v[j][2] * v[j][2] + v[j][3] * v[j][3]); }
                const float rstd = rsqrtf(wave_sum(s2) * (1.0f / D) + LN_EPS);
#pragma unroll
                for (int j = 0; j < 4; ++j) { const int c = 4 * lane + 256 * j;
                    const f32x4 y = v[j] * rstd * lngv[j] + lnbv[j];
                    if (l == 0) { { v2u xo; xo.x = pk2(y[0], y[1]); xo.y = pk2(y[2], y[3]); __builtin_nontemporal_store(xo, (v2u*)(XL + (size_t)r * D + c)); }
                        const f32x4 hv = y * (scv[j] + 1.0f) + shv[j]; *(unsigned*)((unsigned char*)H + (size_t)r * D + c) = pg8::pk4_fp8(hv[0], hv[1], hv[2], hv[3]); }
                    else {
                        __builtin_nontemporal_store(y, (f32x4*)(args.out + (size_t)r * D + c));
                    } }
                } }
            }
#undef CB_TI
#undef CB_DATA
        }
        if (l == 0) SEAM(sb + 4);
    };
    layer_body(std::integral_constant<int, 0>{});
    layer_body(std::integral_constant<int, 1>{});
#undef IN
#undef SEAM
}

extern "C" void kernel_launch(void* const* d_in, const int* in_sizes, int n_in, void* d_out, int out_size, void* d_ws, size_t ws_size, hipStream_t stream) {
    static int grid = 0;
    if (grid == 0) {
        if (n_in != 22 || out_size != TL * D || ws_size < WS_END) { fprintf(stderr, "kernel_launch: unexpected sizes (n_in %d out %d ws %zu)\n", n_in, out_size, ws_size); grid = -1; return; }
        int dev = 0, cus = 0, per_cu = 0;
        if (hipGetDevice(&dev) != hipSuccess || hipDeviceGetAttribute(&cus, hipDeviceAttributeMultiprocessorCount, dev) != hipSuccess) { grid = -1; return; }
        if (hipFuncSetAttribute((const void*)fwd, hipFuncAttributeMaxDynamicSharedMemorySize, LDS_BYTES) != hipSuccess) { fprintf(stderr, "kernel_launch: hipFuncSetAttribute failed\n"); grid = -1; return; }
        if (hipOccupancyMaxActiveBlocksPerMultiprocessor(&per_cu, (const void*)fwd, NWAVES * 64, LDS_BYTES) != hipSuccess || per_cu < 1) fprintf(stderr, "kernel_launch: occupancy query says %d\n", per_cu);
        (void)hipGetLastError();
        grid = cus;
    }
    if (grid < 0) return;
    (void)hipMemsetAsync((char*)d_ws + WS_CTL, 0, CTL_ZERO_BYTES, stream);
    Args a{};
    for (int i = 0; i < 22; ++i) a.in[i] = (const float*)d_in[i];
    a.out = (float*)d_out; a.ws = (unsigned char*)d_ws;
    a.s_lo = 0; a.s_hi = 17;
    hipLaunchKernelGGL(fwd, dim3(grid), dim3(NWAVES * 64), LDS_BYTES, stream, a);
}
```
